# Optimizing an MI355X kernel written in HIP

```python
import jax, jax.numpy as jnp
from jax import lax
import numpy as np

D_MODEL = 4096
BATCH = 2
SEQ = 4096
DEPTH = 1
DEC_BATCH = 16
DEC_SEQ = 64
PAST_LEN = 1024

CHUNK = 64
GMLP_CHUNK = 2 * CHUNK
D_MIX = D_MODEL
C_CONV = 3 * D_MIX // 8
C_GMLP = 3 * D_MIX // 8
C_X = D_MIX - C_CONV - C_GMLP
CONV_W = 31
G_HEADS = 4
G_HEAD_DIM = C_GMLP // G_HEADS
X_HEADS = 4
X_HEAD_DIM = C_X // X_HEADS
N_MEM = 256
N_IN = 3 * C_CONV + 3 * C_GMLP + 2 * C_X
SPLITS = [int(s) for s in np.cumsum([C_CONV, C_CONV, C_CONV, C_GMLP, C_GMLP, C_GMLP, C_X])]
EPS = 1e-6

kernel_name = 'hymba_conformer_gmlp_memxattn_stream_step'


def rms_norm(x, g):
    xf = x.astype(jnp.float32)
    y = xf * lax.rsqrt(jnp.mean(xf * xf, axis=-1, keepdims=True) + EPS)
    return (y * g.astype(jnp.float32)).astype(x.dtype)


def layer_norm(x, g, b):
    xf = x.astype(jnp.float32)
    xc = xf - jnp.mean(xf, axis=-1, keepdims=True)
    y = xc * lax.rsqrt(jnp.mean(xc * xc, axis=-1, keepdims=True) + EPS)
    return (y * g.astype(jnp.float32) + b.astype(jnp.float32)).astype(x.dtype)


def causal_dwconv(hist, w, b):
    out = lax.conv_general_dilated(hist, w[:, None, :], window_strides=(1,), padding='VALID',
                                   dimension_numbers=('NWC', 'WIO', 'NWC'),
                                   feature_group_count=C_CONV)
    return out + b


def spatial_gate(vn, w_s, b_s):
    B, T, _ = vn.shape
    n = -(-T // GMLP_CHUNK)
    vp = jnp.pad(vn, ((0, 0), (0, n * GMLP_CHUNK - T), (0, 0)))
    vp = vp.reshape(B, n, GMLP_CHUNK, G_HEADS, G_HEAD_DIM)
    tri = jnp.tril(jnp.ones((GMLP_CHUNK, GMLP_CHUNK), dtype=bool))
    wm = jnp.where(tri[None], w_s, 0).astype(vp.dtype)
    z = jnp.einsum('hij,bnjhd->bnihd', wm, vp) + b_s.T[None, None, :, :, None]
    return z.reshape(B, n * GMLP_CHUNK, C_GMLP)[:, :T]


def memory_kv(mem, g_mem, w_mk, w_mv):
    B = mem.shape[0]
    m = rms_norm(mem, g_mem)
    k = (m @ w_mk).reshape(B, N_MEM, X_HEADS, X_HEAD_DIM)
    v = (m @ w_mv).reshape(B, N_MEM, X_HEADS, X_HEAD_DIM)
    return k, v


def cross_attend(q, mem_k, mem_v):
    B, T, _ = q.shape
    qh = q.reshape(B, T, X_HEADS, X_HEAD_DIM) * (X_HEAD_DIM ** -0.5)
    s = jnp.einsum('bthd,bmhd->bhtm', qh, mem_k).astype(jnp.float32)
    p = jax.nn.softmax(s, axis=-1).astype(mem_v.dtype)
    return jnp.einsum('bhtm,bmhd->bthd', p, mem_v).reshape(B, T, C_X)


def mixer_layer(x, conv_prev, mem_k, mem_v, g_pre, w_in, conv_w, conv_b, ln_conv_g, ln_conv_b,
                ln_v_g, ln_v_b, w_spatial, b_spatial, g_branch, w_out, g_post):
    h = rms_norm(x, g_pre)
    p = h @ w_in
    a, bg, gc, u, v, gg, q, gx = jnp.split(p, SPLITS, axis=-1)
    glu = a * jax.nn.sigmoid(bg)
    hist = jnp.concatenate([conv_prev, glu], axis=1)
    c = causal_dwconv(hist, conv_w, conv_b)
    yc = jax.nn.silu(layer_norm(c, ln_conv_g, ln_conv_b)) * jax.nn.silu(gc)
    new_conv = hist[:, -(CONV_W - 1):]
    vn = layer_norm(v, ln_v_g, ln_v_b)
    yg = u * spatial_gate(vn, w_spatial, b_spatial) * jax.nn.silu(gg)
    yx = cross_attend(q, mem_k, mem_v) * jax.nn.silu(gx)
    mixed = jnp.concatenate([
        rms_norm(yc, g_branch[:C_CONV]),
        rms_norm(yg, g_branch[C_CONV:C_CONV + C_GMLP]),
        rms_norm(yx, g_branch[C_CONV + C_GMLP:]),
    ], axis=-1)
    out = mixed @ w_out
    return x + rms_norm(out, g_post), new_conv, vn


def setup_inputs(seed: int = 0) -> dict:
    key = jax.random.key(seed)
    ks = jax.random.split(key, 32)
    f32 = jnp.float32
    nrm = lambda k, shape, s=1.0: (s * jax.random.normal(k, shape)).astype(f32)
    gain = lambda k, shape: (1.0 + 0.02 * jax.random.normal(k, shape)).astype(f32)
    return {
        'x_prompt': nrm(ks[0], (BATCH, SEQ, D_MODEL)),
        'x_sample': nrm(ks[1], (DEC_BATCH, DEC_SEQ, D_MODEL)),
        'mem_prompt': nrm(ks[2], (BATCH, N_MEM, D_MODEL)),
        'cache_mem_k': nrm(ks[3], (DEPTH, DEC_BATCH, N_MEM, X_HEADS, X_HEAD_DIM)),
        'cache_mem_v': nrm(ks[4], (DEPTH, DEC_BATCH, N_MEM, X_HEADS, X_HEAD_DIM)),
        'cache_conv': nrm(ks[5], (DEPTH, DEC_BATCH, CONV_W - 1, C_CONV), 0.5),
        'g_pre': gain(ks[6], (DEPTH, D_MODEL)),
        'w_in': nrm(ks[7], (DEPTH, D_MODEL, N_IN), D_MODEL ** -0.5),
        'conv_w': nrm(ks[8], (DEPTH, CONV_W, C_CONV), CONV_W ** -0.5),
        'conv_b': nrm(ks[9], (DEPTH, C_CONV), 0.02),
        'ln_conv_g': gain(ks[10], (DEPTH, C_CONV)),
        'ln_conv_b': nrm(ks[11], (DEPTH, C_CONV), 0.02),
        'ln_v_g': gain(ks[12], (DEPTH, C_GMLP)),
        'ln_v_b': nrm(ks[13], (DEPTH, C_GMLP), 0.02),
        'w_spatial': nrm(ks[14], (DEPTH, G_HEADS, GMLP_CHUNK, GMLP_CHUNK), GMLP_CHUNK ** -0.5),
        'b_spatial': (1.0 + 0.1 * jax.random.normal(ks[15], (DEPTH, G_HEADS, GMLP_CHUNK))).astype(f32),
        'g_mem': gain(ks[16], (DEPTH, D_MODEL)),
        'w_mk': nrm(ks[17], (DEPTH, D_MODEL, C_X), D_MODEL ** -0.5),
        'w_mv': nrm(ks[18], (DEPTH, D_MODEL, C_X), D_MODEL ** -0.5),
        'g_branch': gain(ks[19], (DEPTH, D_MIX)),
        'w_out': nrm(ks[20], (DEPTH, D_MIX, D_MODEL), D_MIX ** -0.5),
        'g_post': gain(ks[21], (DEPTH, D_MODEL)),
    }


def reference(x_prompt, x_sample, mem_prompt, cache_mem_k, cache_mem_v, cache_conv,
              g_pre, w_in, conv_w, conv_b, ln_conv_g, ln_conv_b, ln_v_g, ln_v_b,
              w_spatial, b_spatial, g_mem, w_mk, w_mv, g_branch, w_out, g_post):
    yp, ys = x_prompt, x_sample
    mk_l, mv_l, cp_l, cs_l, gv_l = [], [], [], [], []
    for l in range(DEPTH):
        lw = (g_pre[l], w_in[l], conv_w[l], conv_b[l], ln_conv_g[l], ln_conv_b[l],
              ln_v_g[l], ln_v_b[l], w_spatial[l], b_spatial[l], g_branch[l], w_out[l], g_post[l])
        mk, mv = memory_kv(mem_prompt, g_mem[l], w_mk[l], w_mv[l])
        conv0 = jnp.zeros((yp.shape[0], CONV_W - 1, C_CONV), dtype=yp.dtype)
        yp, cp, _ = mixer_layer(yp, conv0, mk, mv, *lw)
        ys, cs, gv = mixer_layer(ys, cache_conv[l], cache_mem_k[l], cache_mem_v[l], *lw)
        mk_l.append(mk); mv_l.append(mv); cp_l.append(cp); cs_l.append(cs); gv_l.append(gv)
    mem_k_prompt = jnp.stack(mk_l)
    mem_v_prompt = jnp.stack(mv_l)
    conv_prompt = jnp.stack(cp_l)
    conv_sample = jnp.stack(cs_l)
    gmlp_v_sample = jnp.stack(gv_l)
    return (yp, ys, mem_k_prompt, mem_v_prompt, conv_prompt, conv_sample, gmlp_v_sample)
```

```cpp
#include <hip/hip_runtime.h>
#include <hip/hip_cooperative_groups.h>
#include <cstdio>
#include <cstdint>
namespace cg = cooperative_groups;

#define LAS __attribute__((address_space(3)))
typedef unsigned short bf16_t;
typedef short bf16x8 __attribute__((ext_vector_type(8)));
typedef short s16x4 __attribute__((ext_vector_type(4)));
typedef float f32x4 __attribute__((ext_vector_type(4)));
typedef unsigned u32x4 __attribute__((ext_vector_type(4)));
typedef unsigned u32x2 __attribute__((ext_vector_type(2)));

constexpr int DM = 4096;
constexpr int MP = 8192, MS = 1024, MT = MP + MS;
constexpr int NIN = 11264;
constexpr int CC = 1536;
constexpr int CX = 1024;
constexpr int MEMR = 512;
constexpr float EPS = 1e-6f;
constexpr int PW = 5120;
constexpr int P_UG = 0, P_SGC = 1536, P_Q = 3072, P_SGX = 4096;
constexpr int GROWS = MT + 18 * 30;
__device__ __forceinline__ int glu_row(int row) { return row < MP ? row + 30 * ((row >> 12) + 1) : row + 30 * (((row - MP) >> 6) + 3); }
constexpr float QSCALE = 0.0625f * 1.4426950408889634f;

constexpr size_t O_Y = 0, O_MK = (size_t)MT * DM, O_MV = O_MK + 524288, O_CP = O_MV + 524288, O_CS = O_CP + 92160, O_GV = O_CS + 737280;

constexpr size_t MiB = 1u << 20;
constexpr size_t WS_CTL = 0, CTL_BYTES = 262144;
constexpr size_t CTL_BAR = 131072;
constexpr size_t CTL_PCNT = 196608;
constexpr size_t CTL_VSTAT = 4096, CTL_OSS = CTL_VSTAT + (size_t)MT * 8;
static_assert(CTL_OSS + (size_t)MT * 4 <= CTL_BYTES, "ctl");
constexpr size_t WS_WT = 2 * MiB;
constexpr size_t WS_WO = 106 * MiB;
constexpr size_t WS_H = 138 * MiB;
constexpr size_t WS_P = 214 * MiB;
constexpr size_t WS_VT = 332 * MiB;
constexpr size_t WS_KB = 360 * MiB;
constexpr size_t WS_VTM = 370 * MiB;
constexpr size_t WS_MIX = 380 * MiB;
constexpr size_t WS_OUT = 452 * MiB;
constexpr size_t WS_GLU = 524 * MiB;
constexpr size_t WS_QF = 556 * MiB;
constexpr size_t WS_OF = 620 * MiB;
constexpr size_t WS_END = 684 * MiB;
constexpr size_t SLAB = (size_t)4096 * 1024;
static_assert(WS_GLU + (size_t)GROWS * CC * 2 <= WS_END, "glu");
static_assert(WS_WT + (size_t)13312 * 4096 * 2 <= WS_WO && WS_WO + (size_t)4096 * 4096 * 2 <= WS_H && WS_H + (size_t)9728 * 4096 * 2 <= WS_P &&
              WS_P + (size_t)MT * PW * 2 <= WS_VT && WS_VT + (size_t)CC * MT * 2 <= WS_KB && WS_KB + (size_t)18 * 256 * 1024 * 2 <= WS_VTM &&
              WS_VTM + (size_t)18 * 1024 * 256 * 2 <= WS_MIX && WS_MIX + (size_t)MT * DM * 2 <= WS_OUT && WS_OUT + (size_t)MT * DM * 2 <= WS_END, "ws map");

constexpr int LDS_BYTES = 143360;
constexpr int NTHREADS = 512;

__device__ __forceinline__ unsigned cvt_pk_bf16(float lo, float hi) { unsigned r; asm volatile("v_cvt_pk_bf16_f32 %0, %1, %2" : "=v"(r) : "v"(lo), "v"(hi)); return r; }
__device__ __forceinline__ bf16_t f2bf(float f) { return (bf16_t)(cvt_pk_bf16(f, 0.f) & 0xffffu); }
__device__ __forceinline__ float bf2f(bf16_t u) { return __uint_as_float(((unsigned)u) << 16); }
__device__ __forceinline__ float bflo(unsigned u) { return __uint_as_float(u << 16); }
__device__ __forceinline__ float bfhi(unsigned u) { return __uint_as_float(u & 0xffff0000u); }
__device__ __forceinline__ float sigmoidf_(float x) { return __builtin_amdgcn_rcpf(1.0f + __builtin_amdgcn_exp2f(-1.4426950408889634f * x)); }
__device__ __forceinline__ float wave_sum(float v) {
#pragma unroll
    for (int o = 1; o < 64; o <<= 1) v += __shfl_xor(v, o);
    return v;
}
#define LDS_WAIT() asm volatile("s_waitcnt lgkmcnt(0)" ::: "memory")
__device__ __forceinline__ int opq(int x) { asm volatile("" : "+v"(x)); return x; }

namespace pg8 {
constexpr int BM = 256, BK = 64, HALF = 128, HTB = HALF * BK * 2, STAGE_BYTES = 8 * HTB;
__device__ __forceinline__ int lds_byte(int r, int c) { const int st = (r >> 4) * 2 + (c >> 5), rr = r & 15, cc = c & 31, ob = rr * 64 + cc * 2; return st * 1024 + (ob ^ (((ob >> 9) & 1) << 5)); }
__device__ __forceinline__ void stage_rc(int b, int& R, int& C) { const int st = b / 1024, sb = b % 1024, swz = sb ^ (((sb >> 9) & 1) << 5); R = (st >> 1) * 16 + swz / 64; C = (st & 1) * 32 + (swz % 64) / 2; }
__device__ __forceinline__ int perm32(int rho) { const int n = rho >> 4, i = rho & 15; return 8 * (i >> 2) + 4 * n + (i & 3); }
struct Unit { int pm, pn, koff, kt; };
struct Gemm { const bf16_t* A; const bf16_t* Bt; int ld; };

template <class Epi, class Sched>
__device__ __forceinline__ void gemm_phase(LAS unsigned char* lds, const Gemm g, const Sched& S, const Epi& E) {
    const int tid = opq((int)threadIdx.x) & 511, wid = __builtin_amdgcn_readfirstlane(tid >> 6), lane = tid & 63, wr = wid >> 2, wc = wid & 3, fr = lane & 15, fq = lane >> 4;
    const int K = g.ld;
    unsigned voffA[2], voffB[2];
#pragma unroll
    for (int i = 0; i < 2; ++i) { int R, C; stage_rc(tid * 16 + i * 8192, R, C); const int Rb = (R & ~31) + perm32(R & 31);
        voffA[i] = (unsigned)(R * K + C) * 2u; voffB[i] = (unsigned)(Rb * K + C) * 2u; }
    const size_t kstep = (size_t)(BK * 2);
    const size_t hstep = (size_t)HALF * K * 2;
    const size_t tstep = 2 * hstep;
    const unsigned ldsw = (unsigned)wid * 1024u;
    const int aoff = lds_byte(wr * 64 + fr, fq * 8), boff = lds_byte(wc * 32 + fr, fq * 8);
#define PG8_SA(b, h) (((b) * 2 + (h)) * HTB)
#define PG8_SB(b, h) ((4 + (b) * 2 + (h)) * HTB)
#define PG8_STAGE(bufoff, gbase, voff) do { _Pragma("unroll") for (int _i = 0; _i < 2; ++_i) \
        __builtin_amdgcn_global_load_lds((const unsigned*)((const char*)(gbase) + (voff)[_i]), (LAS unsigned*)(lds + (bufoff) + ldsw + _i * 8192), 16, 0, 0); } while (0)
#define PG8_LDA(dst, b, h) do { _Pragma("unroll") for (int m = 0; m < 4; ++m) _Pragma("unroll") for (int k = 0; k < 2; ++k) dst[m][k] = *(const LAS bf16x8*)(lds + PG8_SA(b, h) + aoff + m * 2048 + k * 1024); } while (0)
#define PG8_LDB(dst, b, h) do { _Pragma("unroll") for (int n = 0; n < 2; ++n) _Pragma("unroll") for (int k = 0; k < 2; ++k) dst[n][k] = *(const LAS bf16x8*)(lds + PG8_SB(b, h) + boff + n * 2048 + k * 1024); } while (0)
#define PG8_MMA(ai, bj, At, Bt) do { __builtin_amdgcn_s_setprio(1); _Pragma("unroll") for (int m = 0; m < 4; ++m) _Pragma("unroll") for (int n = 0; n < 2; ++n) _Pragma("unroll") for (int k = 0; k < 2; ++k) \
        acc[ai][bj][m][n] = __builtin_amdgcn_mfma_f32_16x16x32_bf16(Bt[n][k], At[m][k], acc[ai][bj][m][n], 0, 0, 0); __builtin_amdgcn_s_setprio(0); } while (0)
#define PG8_WAIT_V(n) asm volatile("s_waitcnt vmcnt(" #n ")" ::: "memory")
#define PG8_WAIT_L(n) asm volatile("s_waitcnt lgkmcnt(" #n ")" ::: "memory")
#define PG8_BAR __builtin_amdgcn_s_barrier()
#define PG8_SCHED __builtin_amdgcn_sched_barrier(0)
    Unit cur, nxt; int ui = 0;
    if (!S.next(0, cur)) return;
    f32x4 acc[2][2][4][2];
#pragma unroll
    for (int a = 0; a < 2; ++a)
#pragma unroll
        for (int b = 0; b < 2; ++b)
#pragma unroll
            for (int m = 0; m < 4; ++m)
#pragma unroll
                for (int n = 0; n < 2; ++n) acc[a][b][m][n] = (f32x4){0.f, 0.f, 0.f, 0.f};
    bf16x8 At[4][2], B0[2][2], B1[2][2];
    const char* cA = (const char*)g.A + (size_t)cur.pm * tstep + (size_t)cur.koff * 2; const char* cB = (const char*)g.Bt + (size_t)cur.pn * tstep + (size_t)cur.koff * 2;
    PG8_STAGE(PG8_SB(0, 0), cB, voffB); PG8_STAGE(PG8_SB(0, 1), cB + hstep, voffB); PG8_STAGE(PG8_SA(0, 0), cA, voffA); PG8_STAGE(PG8_SA(0, 1), cA + hstep, voffA);
    if (wr == 1) PG8_BAR;
    PG8_WAIT_V(2); PG8_BAR;
    PG8_STAGE(PG8_SB(1, 0), cB + kstep, voffB); PG8_STAGE(PG8_SA(1, 0), cA + kstep, voffA); PG8_STAGE(PG8_SB(1, 1), cB + hstep + kstep, voffB);
    PG8_WAIT_V(6); PG8_BAR;
    for (;;) {
        const bool has_next = S.next(ui + 1, nxt);
        const char* nA = has_next ? (const char*)g.A + (size_t)nxt.pm * tstep + (size_t)nxt.koff * 2 : cA; const char* nB = has_next ? (const char*)g.Bt + (size_t)nxt.pn * tstep + (size_t)nxt.koff * 2 : cB;
        const int nt = cur.kt;
        for (int t = 0; t < nt; t += 2) {
            const bool last = (t == nt - 2);
            const char* a1 = cA + (size_t)(t + 1) * kstep;
            const char* a2 = last ? nA : cA + (size_t)(t + 2) * kstep; const char* b2 = last ? nB : cB + (size_t)(t + 2) * kstep;
            const char* a3 = a2 + kstep; const char* b3 = b2 + kstep;
            PG8_LDB(B0, 0, 0); PG8_LDB(B1, 0, 1); PG8_SCHED; PG8_LDA(At, 0, 0); PG8_STAGE(PG8_SA(1, 1), a1 + hstep, voffA);
            PG8_WAIT_V(8); PG8_WAIT_L(0); PG8_BAR; PG8_MMA(0, 0, At, B0); PG8_MMA(0, 1, At, B1); PG8_BAR; PG8_SCHED;
            PG8_LDA(At, 0, 1); PG8_STAGE(PG8_SB(0, 0), b2, voffB); PG8_STAGE(PG8_SB(0, 1), b2 + hstep, voffB); PG8_STAGE(PG8_SA(0, 0), a2, voffA);
            PG8_WAIT_V(8); PG8_WAIT_L(0); PG8_BAR; PG8_MMA(1, 0, At, B0); PG8_MMA(1, 1, At, B1); PG8_BAR; PG8_SCHED;
            PG8_LDB(B0, 1, 0); PG8_LDB(B1, 1, 1); PG8_SCHED; PG8_LDA(At, 1, 0); PG8_STAGE(PG8_SA(0, 1), a2 + hstep, voffA);
            PG8_WAIT_V(8); PG8_WAIT_L(0); PG8_BAR; PG8_MMA(0, 0, At, B0); PG8_MMA(0, 1, At, B1); PG8_BAR; PG8_SCHED;
            PG8_LDA(At, 1, 1); PG8_STAGE(PG8_SB(1, 0), b3, voffB); PG8_STAGE(PG8_SB(1, 1), b3 + hstep, voffB); PG8_STAGE(PG8_SA(1, 0), a3, voffA);
            PG8_WAIT_V(8); PG8_WAIT_L(0); PG8_BAR; PG8_MMA(1, 0, At, B0); PG8_MMA(1, 1, At, B1); PG8_BAR; PG8_SCHED;
        }
        if (wr == 0) PG8_BAR;
        E(acc, cur, wr, wc, fr, fq);
        if (!has_next) break;
#pragma unroll
        for (int a = 0; a < 2; ++a)
#pragma unroll
            for (int b = 0; b < 2; ++b)
#pragma unroll
                for (int m = 0; m < 4; ++m)
#pragma unroll
                    for (int n = 0; n < 2; ++n) acc[a][b][m][n] = (f32x4){0.f, 0.f, 0.f, 0.f};
        cur = nxt; cA = nA; cB = nB; ++ui;
        if (wr == 1) PG8_BAR;
    }
    PG8_WAIT_V(0);
    PG8_BAR;
#undef PG8_SA
#undef PG8_SB
#undef PG8_STAGE
#undef PG8_LDA
#undef PG8_LDB
#undef PG8_MMA
#undef PG8_WAIT_V
#undef PG8_WAIT_L
#undef PG8_BAR
#undef PG8_SCHED
}
}

__device__ __forceinline__ void static_unit(int L, int nM, int nN, pg8::Unit& u) {
    const int nwg = nM * nN;
    int wgid = L; { const int q = nwg / 8, r = nwg % 8, xcd = wgid % 8, off = wgid / 8; wgid = (xcd < r ? xcd * (q + 1) : r * (q + 1) + (xcd - r) * q) + off; }
    const int nig = 8 * nN, gid = wgid / nig, fm = gid * 8, gsz = (nM - fm) < 8 ? (nM - fm) : 8;
    u.pm = fm + ((wgid % nig) % gsz); u.pn = (wgid % nig) / gsz; u.koff = 0; u.kt = 64;
}
__device__ __forceinline__ void g1_full_unit(int L, pg8::Unit& u) {
    pg8::Unit t; static_unit(L < 1440 ? L : 0, 36, 40, t); if (t.pn >= 36) t.pn += 4;
    const int r = L - 1440; const bool tail = L >= 1440, isq = r < 80;
    u.pm = tail ? (isq ? 16 + (r >> 2) : 36 + ((r - 80) >> 3)) : t.pm; u.pn = tail ? (isq ? 36 + (r & 3) : 44 + ((r - 80) & 7)) : t.pn; u.koff = 0; u.kt = 64;
}
struct Sched1 {
    int c;
    __device__ __forceinline__ bool next(int i, pg8::Unit& u) const {
        if (i >= 7) return false;
        const bool qfirst = (c & 4) != 0; const bool isq = (i == (qfirst ? 0 : 6));
        pg8::Unit f; g1_full_unit((qfirst ? (i > 0 ? i - 1 : 0) : (i < 6 ? i : 0)) * 256 + c, f);
        const int xcd = c & 7, j = c >> 3;
        u.pm = isq ? 2 * xcd + (j >> 4) : f.pm; u.pn = isq ? 36 + ((j & 15) >> 2) : f.pn; u.koff = isq ? 1024 * (j & 3) : 0; u.kt = isq ? 16 : 64;
        return true;
    }
};
struct Sched2 {
    int c;
    __device__ __forceinline__ bool next(int i, pg8::Unit& u) const {
        if (i >= 3) return false;
        const bool qfirst = (c & 4) != 0; const bool isq = (i == (qfirst ? 0 : 2));
        const int xcd = c & 7, j = c >> 3, r = qfirst ? i - 1 : i;
        u.pm = isq ? 32 + (xcd >> 1) : 16 * r + 2 * xcd + (j >> 4); u.pn = j & 15; u.koff = isq ? 1024 * (2 * (xcd & 1) + (j >> 4)) : 0; u.kt = isq ? 16 : 64;
        return true;
    }
};

struct Epi1 {
    bf16_t* P; bf16_t* GLU; bf16_t* VT; float* vstat; float* out; bf16_t* KB; bf16_t* VTM;
    __device__ __forceinline__ void operator()(const f32x4 (&acc)[2][2][4][2], const pg8::Unit& u, int wr, int wc, int fr, int fq) const {
        asm volatile("" : "+v"(fr), "+v"(fq));
        const int pm = u.pm, pn = u.pn;
        const int rb = pm * 256 + wr * 64 + fr;
        const int cl = wc * 32 + 8 * fq;
        if (pn < 24) {
            const bool isglu = pn < 12; const int t = isglu ? pn : pn - 12;
            bf16_t* base = (isglu ? GLU : P + P_UG) + t * 128 + cl;
#pragma unroll
            for (int ai = 0; ai < 2; ++ai)
#pragma unroll
                for (int m = 0; m < 4; ++m) {
                    const int row = rb + ai * 128 + m * 16;
                    f32x4 r0, r1; const f32x4 x0 = acc[ai][0][m][0], x1 = acc[ai][0][m][1], g0 = acc[ai][1][m][0], g1 = acc[ai][1][m][1];
#pragma unroll
                    for (int j = 0; j < 4; ++j) {
                        float s0 = sigmoidf_(g0[j]), s1 = sigmoidf_(g1[j]);
                        if (!isglu) { s0 *= g0[j]; s1 *= g1[j]; }
                        r0[j] = x0[j] * s0; r1[j] = x1[j] * s1;
                    }
                    u32x4 w; w.x = cvt_pk_bf16(r0[0], r0[1]); w.y = cvt_pk_bf16(r0[2], r0[3]); w.z = cvt_pk_bf16(r1[0], r1[1]); w.w = cvt_pk_bf16(r1[2], r1[3]);
                    *(u32x4*)(base + (isglu ? (size_t)glu_row(row) * CC : (size_t)row * PW)) = w;
                    if (isglu) {
                        float* dst = nullptr;
                        if (row < MP) { const int tt = row & 4095; if (tt >= 4066) dst = out + O_CP + ((size_t)(row >> 12) * 30 + (tt - 4066)) * CC; }
                        else { const int rr = row - MP, tt = rr & 63; if (tt >= 34) dst = out + O_CS + ((size_t)(rr >> 6) * 30 + (tt - 34)) * CC; }
                        if (dst) { dst += t * 128 + cl; *(f32x4*)dst = r0; *(f32x4*)(dst + 4) = r1; }
                    }
                }
        } else if (pn < 30 || (pn >= 36 && pn < 44)) {
            int cb; bool act = true;
            if (pn < 30) cb = P_SGC + (pn - 24) * 256; else if (pn < 40) { cb = P_Q + (pn - 36) * 256; act = false; } else cb = P_SGX + (pn - 40) * 256;
            bf16_t* base = P + cb + cl;
#pragma unroll
            for (int ai = 0; ai < 2; ++ai)
#pragma unroll
                for (int m = 0; m < 4; ++m) {
                    const int row = rb + ai * 128 + m * 16;
#pragma unroll
                    for (int bj = 0; bj < 2; ++bj) {
                        f32x4 v0 = acc[ai][bj][m][0], v1 = acc[ai][bj][m][1];
#pragma unroll
                        for (int j = 0; j < 4; ++j) {
                            if (act) { v0[j] *= sigmoidf_(v0[j]); v1[j] *= sigmoidf_(v1[j]); } else { v0[j] *= QSCALE; v1[j] *= QSCALE; }
                        }
                        u32x4 w; w.x = cvt_pk_bf16(v0[0], v0[1]); w.y = cvt_pk_bf16(v0[2], v0[3]); w.z = cvt_pk_bf16(v1[0], v1[1]); w.w = cvt_pk_bf16(v1[2], v1[3]);
                        *(u32x4*)(base + (size_t)row * PW + bj * 128) = w;
                    }
                }
        } else if (pn < 36) {
            const int c0 = (pn - 30) * 256 + cl;
#pragma unroll
            for (int ai = 0; ai < 2; ++ai)
#pragma unroll
                for (int m = 0; m < 4; ++m) {
                    const int row = rb + ai * 128 + m * 16;
                    float s = 0.f, q = 0.f;
#pragma unroll
                    for (int bj = 0; bj < 2; ++bj)
#pragma unroll
                        for (int n = 0; n < 2; ++n) {
                            const f32x4 v = acc[ai][bj][m][n];
#pragma unroll
                            for (int j = 0; j < 4; ++j) { s += v[j]; q += v[j] * v[j]; VT[(size_t)(c0 + bj * 128 + 4 * n + j) * MT + row] = f2bf(v[j]); }
                        }
                    s += __shfl_xor(s, 16); s += __shfl_xor(s, 32); q += __shfl_xor(q, 16); q += __shfl_xor(q, 32);
                    if (fq == 0) { atomicAdd(vstat + 2 * row, s); atomicAdd(vstat + 2 * row + 1, q); }
                    if (row >= MP) {
                        float* dst = out + O_GV + (size_t)(row - MP) * CC + c0;
#pragma unroll
                        for (int bj = 0; bj < 2; ++bj) { *(f32x4*)(dst + bj * 128) = acc[ai][bj][m][0]; *(f32x4*)(dst + bj * 128 + 4) = acc[ai][bj][m][1]; }
                    }
                }
        } else {
            const int b = pm - 36, hh = (pn - 44) & 3; const bool isv = pn >= 48;
            float* fo = out + (isv ? O_MV : O_MK);
#pragma unroll
            for (int ai = 0; ai < 2; ++ai)
#pragma unroll
                for (int m = 0; m < 4; ++m) {
                    const int mr = wr * 64 + fr + ai * 128 + m * 16;
                    const size_t rowg = (size_t)b * 256 + mr;
#pragma unroll
                    for (int bj = 0; bj < 2; ++bj) {
                        const f32x4 v0 = acc[ai][bj][m][0], v1 = acc[ai][bj][m][1];
                        const int d0 = bj * 128 + cl;
                        float* dst = fo + rowg * 1024 + hh * 256 + d0; *(f32x4*)dst = v0; *(f32x4*)(dst + 4) = v1;
                        if (!isv) {
                            u32x4 w; w.x = cvt_pk_bf16(v0[0], v0[1]); w.y = cvt_pk_bf16(v0[2], v0[3]); w.z = cvt_pk_bf16(v1[0], v1[1]); w.w = cvt_pk_bf16(v1[2], v1[3]);
                            *(u32x4*)(KB + rowg * 1024 + hh * 256 + d0) = w;
                        } else {
#pragma unroll
                            for (int j = 0; j < 4; ++j) { VTM[((size_t)(b * 4 + hh) * 256 + d0 + j) * 256 + mr] = f2bf(v0[j]); VTM[((size_t)(b * 4 + hh) * 256 + d0 + 4 + j) * 256 + mr] = f2bf(v1[j]); }
                        }
                    }
                }
        }
    }
};

struct Epi2F {
    const float* xp; const float* gpost; float* y; float* oss; unsigned* cnt;
    __device__ __forceinline__ void operator()(const f32x4 (&acc)[2][2][4][2], const pg8::Unit& u, int wr, int wc, int fr, int fq) const {
        asm volatile("" : "+v"(fr), "+v"(fq));
        const int rb = u.pm * 256 + wr * 64 + fr;
#pragma unroll
        for (int ai = 0; ai < 2; ++ai)
#pragma unroll
            for (int m = 0; m < 4; ++m) {
                float q = 0.f;
#pragma unroll
                for (int bj = 0; bj < 2; ++bj) {
                    const f32x4 v0 = acc[ai][bj][m][0], v1 = acc[ai][bj][m][1];
                    q += (v0[0] * v0[0] + v0[1] * v0[1]) + (v0[2] * v0[2] + v0[3] * v0[3]) + (v1[0] * v1[0] + v1[1] * v1[1]) + (v1[2] * v1[2] + v1[3] * v1[3]);
                }
                q += __shfl_xor(q, 16); q += __shfl_xor(q, 32);
                if (fq == 0) (void)__hip_atomic_fetch_add(oss + rb + ai * 128 + m * 16, q, __ATOMIC_RELAXED, __HIP_MEMORY_SCOPE_AGENT);
            }
        const int c0 = u.pn * 256 + wc * 32 + 8 * fq;
        f32x4 gp[2][2];
#pragma unroll
        for (int bj = 0; bj < 2; ++bj) { gp[bj][0] = *(const f32x4*)(gpost + c0 + bj * 128); gp[bj][1] = *(const f32x4*)(gpost + c0 + bj * 128 + 4); }
        f32x4 pre[2][2][2];
#pragma unroll
        for (int m = 0; m < 2; ++m)
#pragma unroll
            for (int bj = 0; bj < 2; ++bj) { const size_t off = (size_t)(rb + m * 16) * DM + c0 + bj * 128; pre[m][bj][0] = __builtin_nontemporal_load((const f32x4*)(xp + off)); pre[m][bj][1] = __builtin_nontemporal_load((const f32x4*)(xp + off + 4)); }
        asm volatile("s_waitcnt vmcnt(0)" ::: "memory");
        __builtin_amdgcn_s_barrier();
        if (threadIdx.x == 0) {
            unsigned* cw = cnt + 64 * u.pm;
            (void)__hip_atomic_fetch_add(cw, 1u, __ATOMIC_RELAXED, __HIP_MEMORY_SCOPE_AGENT);
            unsigned sp = 0;
            while (__hip_atomic_load(cw, __ATOMIC_RELAXED, __HIP_MEMORY_SCOPE_AGENT) < 16u) { __builtin_amdgcn_s_sleep(2); if (++sp > (1u << 22)) break; }
        }
        __builtin_amdgcn_s_barrier();
        asm volatile("" ::: "memory");
#pragma unroll
        for (int ai = 0; ai < 2; ++ai)
#pragma unroll
            for (int m = 0; m < 4; ++m) {
                const int row = rb + ai * 128 + m * 16;
                const float tot = __hip_atomic_load(oss + row, __ATOMIC_RELAXED, __HIP_MEMORY_SCOPE_AGENT);
                const float rs = rsqrtf(tot * (1.0f / DM) + EPS);
#pragma unroll
                for (int bj = 0; bj < 2; ++bj) {
                    const size_t off = (size_t)row * DM + c0 + bj * 128;
                    const f32x4 x0 = (ai == 0 && m < 2) ? pre[m & 1][bj][0] : __builtin_nontemporal_load((const f32x4*)(xp + off)), x1 = (ai == 0 && m < 2) ? pre[m & 1][bj][1] : __builtin_nontemporal_load((const f32x4*)(xp + off + 4));
                    __builtin_nontemporal_store(x0 + acc[ai][bj][m][0] * rs * gp[bj][0], (f32x4*)(y + off)); __builtin_nontemporal_store(x1 + acc[ai][bj][m][1] * rs * gp[bj][1], (f32x4*)(y + off + 4));
                }
            }
    }
};
struct EpiSlab {
    bf16_t* F; int ldf, pm0, pn0; size_t slab;
    __device__ __forceinline__ void operator()(const f32x4 (&acc)[2][2][4][2], const pg8::Unit& u, int wr, int wc, int fr, int fq) const {
        asm volatile("" : "+v"(fr), "+v"(fq));
        const int rb = (u.pm - pm0) * 256 + wr * 64 + fr;
        bf16_t* base = F + (size_t)(u.koff >> 10) * slab + (u.pn - pn0) * 256 + wc * 32 + 8 * fq;
#pragma unroll
        for (int ai = 0; ai < 2; ++ai)
#pragma unroll
            for (int m = 0; m < 4; ++m) {
                bf16_t* rp = base + (size_t)(rb + ai * 128 + m * 16) * ldf;
#pragma unroll
                for (int bj = 0; bj < 2; ++bj) { const f32x4 v0 = acc[ai][bj][m][0], v1 = acc[ai][bj][m][1];
                    u32x4 w; w.x = cvt_pk_bf16(v0[0], v0[1]); w.y = cvt_pk_bf16(v0[2], v0[3]); w.z = cvt_pk_bf16(v1[0], v1[1]); w.w = cvt_pk_bf16(v1[2], v1[3]);
                    *(u32x4*)(rp + bj * 128) = w; }
            }
    }
};

template <class EF>
struct EpiMix {
    EF f; EpiSlab q;
    __device__ __forceinline__ void operator()(const f32x4 (&acc)[2][2][4][2], const pg8::Unit& u, int wr, int wc, int fr, int fq) const {
        if (u.kt == 64) f(acc, u, wr, wc, fr, fq); else q(acc, u, wr, wc, fr, fq);
    }
};

__device__ __forceinline__ void transpose_item64(const float* __restrict__ W, int N, bf16_t* __restrict__ WT, int K, int k0, int n0, int drow0, LAS float* scr, int lane) {
    const int lr = lane >> 4, lc = (lane & 15) * 4;
    f32x4 v[16];
#pragma unroll
    for (int i = 0; i < 16; ++i) v[i] = __builtin_nontemporal_load((const f32x4*)(W + (size_t)(k0 + 4 * i + lr) * N + n0 + lc));
#pragma unroll
    for (int i = 0; i < 16; ++i) { LAS float* p = scr + (4 * i + lr) * 65 + lc; p[0] = v[i][0]; p[1] = v[i][1]; p[2] = v[i][2]; p[3] = v[i][3]; }
    LDS_WAIT();
    const int c = lane & 7, nr = lane >> 3;
#pragma unroll
    for (int j = 0; j < 8; ++j) {
        const int n = nr + 8 * j; const LAS float* s = scr + (8 * c) * 65 + n;
        u32x4 o; o.x = cvt_pk_bf16(s[0], s[65]); o.y = cvt_pk_bf16(s[130], s[195]); o.z = cvt_pk_bf16(s[260], s[325]); o.w = cvt_pk_bf16(s[390], s[455]);
        *(u32x4*)(WT + (size_t)(drow0 + n0 + n) * K + k0 + 8 * c) = o;
    }
    LDS_WAIT();
}
__device__ __forceinline__ int win_dest_row(int n) {
    if (n < 1536) return 256 * (n >> 7) + (n & 127);
    if (n < 3072) { n -= 1536; return 256 * (n >> 7) + 128 + (n & 127); }
    if (n < 4608) return 256 * 24 + (n - 3072);
    if (n < 6144) { n -= 4608; return 256 * (12 + (n >> 7)) + (n & 127); }
    if (n < 7680) return 256 * 30 + (n - 6144);
    if (n < 9216) { n -= 7680; return 256 * (12 + (n >> 7)) + 128 + (n & 127); }
    if (n < 10240) return 256 * 36 + (n - 9216);
    return 256 * 40 + (n - 10240);
}
__device__ __forceinline__ void rms_row_bf16(const float* __restrict__ xrow, const float* __restrict__ g, bf16_t* __restrict__ orow, int lane) {
    f32x4 v[16]; float s = 0.f;
#pragma unroll
    for (int j = 0; j < 16; ++j) { v[j] = __builtin_nontemporal_load((const f32x4*)xrow + lane + 64 * j); s += (v[j][0] * v[j][0] + v[j][1] * v[j][1]) + (v[j][2] * v[j][2] + v[j][3] * v[j][3]); }
    s = wave_sum(s);
    const float r = rsqrtf(s * (1.0f / DM) + EPS);
#pragma unroll
    for (int j = 0; j < 16; ++j) {
        const f32x4 gg = ((const f32x4*)g)[lane + 64 * j];
        u32x2 o; o.x = cvt_pk_bf16(v[j][0] * r * gg[0], v[j][1] * r * gg[1]); o.y = cvt_pk_bf16(v[j][2] * r * gg[2], v[j][3] * r * gg[3]);
        ((u32x2*)orow)[lane + 64 * j] = o;
    }
}

#define XB_TMO      128
#define XB_XCNT(j)  (256  + 64 * (j))
#define XB_XSUB(j)  (1280 + 64 * (j))
#define XB_XGEN(j)  (2304 + 64 * (j))
#define XB_TOP      3328
#define XB_TOPGEN   3392
#define XB_SPIN_CAP (1u << 20)
__device__ __forceinline__ unsigned xb_ld(unsigned* p)              { return __hip_atomic_load(p, __ATOMIC_RELAXED, __HIP_MEMORY_SCOPE_AGENT); }
__device__ __forceinline__ unsigned xb_add(unsigned* p, unsigned v) { return __hip_atomic_fetch_add(p, v, __ATOMIC_RELAXED, __HIP_MEMORY_SCOPE_AGENT); }
__device__ __forceinline__ unsigned xb_xcc_id() { return (unsigned)__builtin_amdgcn_s_getreg((3 << 11) | 20) & 0xFu; }
#define XB_SPIN(cond, bar) do { unsigned _sp = 0; while (cond) { __builtin_amdgcn_s_sleep(1); \
    if ((++_sp & 255u) == 0u) { if (xb_ld(&(bar)[XB_TMO])) break; if (_sp > XB_SPIN_CAP) { atomicAdd(&(bar)[XB_TMO], 1u); break; } } } } while (0)
struct XcdBarrier { unsigned* bar; unsigned x; volatile LAS unsigned* st; };
__device__ __forceinline__ XcdBarrier xcd_barrier_post(unsigned* bar, volatile LAS unsigned* st) {
    XcdBarrier b; b.bar = bar; b.x = xb_xcc_id(); b.st = st;
    if (threadIdx.x == 0) (void)xb_add(&bar[XB_XCNT(b.x)], 1u);
    return b;
}
__device__ __forceinline__ void xcd_barrier_complete(unsigned* bar, unsigned x, unsigned& nloc, unsigned& nx) {
    const unsigned G = gridDim.x * gridDim.y * gridDim.z;
    unsigned sum, cnt, mine, sp = 0u;
    for (;;) {
        sum = 0u; cnt = 0u; mine = 0u;
#pragma unroll
        for (unsigned j = 0; j < 16; ++j) { const unsigned c = xb_ld(&bar[XB_XCNT(j)]); sum += c; cnt += (c > 0u) ? 1u : 0u; mine = (j == x) ? c : mine; }
        if (sum == G) break;
        __builtin_amdgcn_s_sleep(1);
        if ((++sp & 255u) == 0u) { if (xb_ld(&bar[XB_TMO])) break; if (sp > XB_SPIN_CAP) { atomicAdd(&bar[XB_TMO], 1u); break; } }
    }
    nloc = mine > 0u ? mine : 1u; nx = cnt > 0u ? cnt : 1u;
}
__device__ __forceinline__ void xcd_barrier(const XcdBarrier& b) {
    asm volatile("s_waitcnt vmcnt(0)" ::: "memory");
    __syncthreads();
    if (threadIdx.x == 0) {
        unsigned* bar = b.bar;
        __builtin_amdgcn_s_waitcnt(0);
        unsigned nloc = b.st[0], nx = b.st[1];
        if (nloc == 0u) { xcd_barrier_complete(bar, b.x, nloc, nx); b.st[0] = nloc; b.st[1] = nx; }
        const unsigned old = xb_add(&bar[XB_XSUB(b.x)], 1u);
        const unsigned gen = old / nloc;
        if (old + 1u == (gen + 1u) * nloc) {
            __builtin_amdgcn_fence(__ATOMIC_RELEASE, "agent");
            asm volatile("s_waitcnt vmcnt(0)" ::: "memory");
            const unsigned og = xb_add(&bar[XB_TOP], 1u);
            const unsigned tg = og / nx;
            if (og + 1u == (tg + 1u) * nx) xb_add(&bar[XB_TOPGEN], 1u);
            else XB_SPIN(xb_ld(&bar[XB_TOPGEN]) == tg, bar);
            __builtin_amdgcn_fence(__ATOMIC_ACQUIRE, "agent");
            xb_add(&bar[XB_XGEN(b.x)], 1u);
            asm volatile("s_waitcnt vmcnt(0)" ::: "memory");
        } else {
            XB_SPIN(xb_ld(&bar[XB_XGEN(b.x)]) == gen, bar);
            __builtin_amdgcn_fence(__ATOMIC_ACQUIRE, "agent");
            asm volatile("s_waitcnt vmcnt(0)" ::: "memory");
        }
    }
    __syncthreads();
}

struct Args {
    const float* in[22]; float* out; unsigned char* ws;
};

constexpr int KVB = 512;
__device__ __forceinline__ int kv_off(int row, int chunk) { return row * KVB + ((chunk ^ ((row & 15) ^ (((row >> 4) & 1) << 2))) << 4); }
constexpr int KVH = 128 * KVB;
__device__ __forceinline__ void attn_dma(const bf16_t* base, int pitch, LAS unsigned char* buf, int wave, int lane) {
#pragma unroll
    for (int i = 0; i < 8; ++i) {
        const int r = 2 * (8 * wave + i) + (lane >> 5), cs = lane & 31, cg = cs ^ ((r & 15) ^ (((r >> 4) & 1) << 2));
        __builtin_amdgcn_global_load_lds((const unsigned*)(base + (size_t)r * pitch + cg * 8), (LAS unsigned*)(buf + (8 * wave + i) * 1024), 16, 0, 0);
    }
}
#define ATTN_LAND() do { asm volatile("s_waitcnt vmcnt(0)" ::: "memory"); __syncthreads(); } while (0)
__device__ __forceinline__ float attn_epi8(const f32x4 (&o)[8], float inv, const bf16_t* P, bf16_t* MIX, int qrow, int c0, int g) {
    float ss = 0.f;
#pragma unroll
    for (int p = 0; p < 4; ++p) {
        const int c = c0 + 32 * p + 8 * g;
        const u32x4 sg = *(const u32x4*)(P + (size_t)qrow * PW + P_SGX + c);
        f32x4 y0 = o[2 * p] * inv, y1 = o[2 * p + 1] * inv;
        y0[0] *= bflo(sg.x); y0[1] *= bfhi(sg.x); y0[2] *= bflo(sg.y); y0[3] *= bfhi(sg.y);
        y1[0] *= bflo(sg.z); y1[1] *= bfhi(sg.z); y1[2] *= bflo(sg.w); y1[3] *= bfhi(sg.w);
        ss += ((y0[0] * y0[0] + y0[1] * y0[1]) + (y0[2] * y0[2] + y0[3] * y0[3])) + ((y1[0] * y1[0] + y1[1] * y1[1]) + (y1[2] * y1[2] + y1[3] * y1[3]));
        u32x4 w; w.x = cvt_pk_bf16(y0[0], y0[1]); w.y = cvt_pk_bf16(y0[2], y0[3]); w.z = cvt_pk_bf16(y1[0], y1[1]); w.w = cvt_pk_bf16(y1[2], y1[3]);
        *(u32x4*)(MIX + (size_t)qrow * DM + 3072 + c) = w;
    }
    return ss;
}
__device__ __forceinline__ void attn_unit(int a, const bf16_t* P, const bf16_t* QF, const bf16_t* KB, const bf16_t* VTM, const float* g_branch,
                                          bf16_t* MIX, LAS unsigned char* kv, int tid, int wave, int lane) {
    int row0, bm, nq;
    if (a < 64) { row0 = a * 128; bm = a >> 5; nq = 8; } else { row0 = MP + (a - 64) * 64; bm = 2 + (a - 64); nq = 4; }
    const bool active = wave < nq;
    const int l150 = lane & 15, g0 = lane >> 4, l15 = l150, g = g0;
    const int qrow = row0 + 16 * (active ? wave : 0) + l15;
    const bf16_t* kg = KB + (size_t)(bm * 256) * 1024;
    const bf16_t* vg = VTM + (size_t)(bm * 4) * 256 * 256;
    const int krow0 = 8 * (l15 >> 2) + (l15 & 3);
    LAS unsigned char* bufA = kv; LAS unsigned char* bufB = kv + KVH;
    attn_dma(kg, 1024, bufA, wave, opq(lane));
    ATTN_LAND();
    float ss = 0.f;
#pragma unroll 1
    for (int h = 0; h < 4; ++h) {
        attn_dma(kg + h * 256 + (size_t)128 * 1024, 1024, bufB, wave, opq(lane));
        bf16x8 qf[8];
        if (active) {
            if (row0 < 4096) {
#pragma unroll
                for (int ks = 0; ks < 8; ++ks) {
                    const bf16_t* qp = QF + (size_t)qrow * CX + h * 256 + 32 * ks + 8 * g;
                    const u32x4 p0 = *(const u32x4*)qp, p1 = *(const u32x4*)(qp + SLAB), p2 = *(const u32x4*)(qp + 2 * SLAB), p3 = *(const u32x4*)(qp + 3 * SLAB);
                    u32x4 w;
#pragma unroll
                    for (int e = 0; e < 4; ++e) w[e] = cvt_pk_bf16(((bflo(p0[e]) + bflo(p1[e])) + (bflo(p2[e]) + bflo(p3[e]))) * QSCALE, ((bfhi(p0[e]) + bfhi(p1[e])) + (bfhi(p2[e]) + bfhi(p3[e]))) * QSCALE);
                    qf[ks] = __builtin_bit_cast(bf16x8, w);
                }
            } else {
#pragma unroll
                for (int ks = 0; ks < 8; ++ks) qf[ks] = *(const bf16x8*)(P + (size_t)qrow * PW + P_Q + h * 256 + 32 * ks + 8 * g);
            }
        }
        f32x4 s[16];
        if (active) {
            const int krow = opq(krow0), g = opq(g0);
#pragma unroll
            for (int kt = 0; kt < 16; ++kt) s[kt] = (f32x4){0.f, 0.f, 0.f, 0.f};
#pragma unroll
            for (int ks = 0; ks < 8; ++ks)
                {
#pragma unroll
                  for (int kt = 0; kt < 8; ++kt) s[kt] = __builtin_amdgcn_mfma_f32_16x16x32_bf16(*(const LAS bf16x8*)(bufA + kv_off(32 * (kt >> 1) + 4 * (kt & 1) + krow, 4 * ks + g)), qf[ks], s[kt], 0, 0, 0);
                  __builtin_amdgcn_sched_barrier(0); }
        }
        ATTN_LAND();
        attn_dma(vg + (size_t)h * 256 * 256, 256, bufA, wave, opq(lane));
        bf16x8 pf[8]; float inv = 0.f;
        if (active) {
            const int krow = opq(krow0), g = opq(g0);
#pragma unroll
            for (int ks = 0; ks < 8; ++ks)
                {
#pragma unroll
                  for (int kt = 8; kt < 16; ++kt) s[kt] = __builtin_amdgcn_mfma_f32_16x16x32_bf16(*(const LAS bf16x8*)(bufB + kv_off(32 * ((kt - 8) >> 1) + 4 * (kt & 1) + krow, 4 * ks + g)), qf[ks], s[kt], 0, 0, 0);
                  __builtin_amdgcn_sched_barrier(0); }
            float mx = s[0][0];
#pragma unroll
            for (int kt = 0; kt < 16; ++kt)
#pragma unroll
                for (int j = 0; j < 4; ++j) mx = fmaxf(mx, s[kt][j]);
            mx = fmaxf(mx, __shfl_xor(mx, 16)); mx = fmaxf(mx, __shfl_xor(mx, 32));
            float l = 0.f;
#pragma unroll
            for (int kt = 0; kt < 16; ++kt)
#pragma unroll
                for (int j = 0; j < 4; ++j) { const float p = __builtin_amdgcn_exp2f(s[kt][j] - mx); s[kt][j] = p; l += p; }
            l += __shfl_xor(l, 16); l += __shfl_xor(l, 32);
            inv = 1.0f / l;
#pragma unroll
            for (int si = 0; si < 8; ++si) {
                u32x4 w; w.x = cvt_pk_bf16(s[2 * si][0], s[2 * si][1]); w.y = cvt_pk_bf16(s[2 * si][2], s[2 * si][3]);
                w.z = cvt_pk_bf16(s[2 * si + 1][0], s[2 * si + 1][1]); w.w = cvt_pk_bf16(s[2 * si + 1][2], s[2 * si + 1][3]);
                pf[si] = __builtin_bit_cast(bf16x8, w);
            }
        }
        ATTN_LAND();
        attn_dma(vg + (size_t)h * 256 * 256 + (size_t)128 * 256, 256, bufB, wave, opq(lane));
        if (active) {
            const int krow = opq(krow0), g = opq(g0);
            f32x4 o[8];
#pragma unroll
            for (int dt = 0; dt < 8; ++dt) o[dt] = (f32x4){0.f, 0.f, 0.f, 0.f};
#pragma unroll
            for (int si = 0; si < 8; ++si)
                {
#pragma unroll
                  for (int dt = 0; dt < 8; ++dt) o[dt] = __builtin_amdgcn_mfma_f32_16x16x32_bf16(*(const LAS bf16x8*)(bufA + kv_off(32 * (dt >> 1) + 4 * (dt & 1) + krow, 4 * si + g)), pf[si], o[dt], 0, 0, 0);
                  __builtin_amdgcn_sched_barrier(0); }
            ss += attn_epi8(o, inv, P, MIX, qrow, h * 256, g);
        }
        ATTN_LAND();
        if (h < 3) attn_dma(kg + (h + 1) * 256, 1024, bufA, wave, opq(lane));
        if (active) {
            const int krow = opq(krow0), g = opq(g0);
            f32x4 o[8];
#pragma unroll
            for (int dt = 0; dt < 8; ++dt) o[dt] = (f32x4){0.f, 0.f, 0.f, 0.f};
#pragma unroll
            for (int si = 0; si < 8; ++si)
                {
#pragma unroll
                  for (int dt = 0; dt < 8; ++dt) o[dt] = __builtin_amdgcn_mfma_f32_16x16x32_bf16(*(const LAS bf16x8*)(bufB + kv_off(32 * (dt >> 1) + 4 * (dt & 1) + krow, 4 * si + g)), pf[si], o[dt], 0, 0, 0);
                  __builtin_amdgcn_sched_barrier(0); }
            ss += attn_epi8(o, inv, P, MIX, qrow, h * 256 + 128, g);
        }
        ATTN_LAND();
    }
    if (active) {
        ss += __shfl_xor(ss, 16); ss += __shfl_xor(ss, 32);
        const float rs = rsqrtf(ss * (1.0f / CX) + EPS);
        asm volatile("s_waitcnt vmcnt(0)" ::: "memory");
#pragma unroll 1
        for (int b = 0; b < 4; ++b) {
            bf16_t* mp = MIX + (size_t)qrow * DM + 3072 + 256 * b + 8 * g;
            u32x4 yv[8];
#pragma unroll
            for (int i = 0; i < 8; ++i) yv[i] = *(const u32x4*)(mp + 32 * i);
#pragma unroll
            for (int i = 0; i < 8; ++i) {
                const float* gp = g_branch + 3072 + 256 * b + 32 * i + 8 * g;
                const f32x4 g0v = *(const f32x4*)gp, g1v = *(const f32x4*)(gp + 4);
                u32x4 w; w.x = cvt_pk_bf16(bflo(yv[i].x) * rs * g0v[0], bfhi(yv[i].x) * rs * g0v[1]); w.y = cvt_pk_bf16(bflo(yv[i].y) * rs * g0v[2], bfhi(yv[i].y) * rs * g0v[3]);
                w.z = cvt_pk_bf16(bflo(yv[i].z) * rs * g1v[0], bfhi(yv[i].z) * rs * g1v[1]); w.w = cvt_pk_bf16(bflo(yv[i].w) * rs * g1v[2], bfhi(yv[i].w) * rs * g1v[3]);
                *(u32x4*)(mp + 32 * i) = w;
            }
        }
    }
    __syncthreads();
}

__device__ __forceinline__ void gmlp_unit(int u, const bf16_t* P, const bf16_t* VT, const float* vstat, const float* Ws, const float* bsp,
                                          const float* lvg, const float* lvb, const float* g_branch, float* GV, bf16_t* MIX,
                                          LAS float* sm, int tid, int wave, int lane) {
    int row0, ib; bool sample;
    if (u < 512) { row0 = (u >> 3) * 128; ib = u & 7; sample = false; } else { const int v = u - 512; row0 = MP + (v >> 2) * 64; ib = v & 3; sample = true; }
    const int i0 = 16 * ib, nks = (i0 + 47) >> 5, nj = i0 + 16;
    LAS float* sm_mean = sm; LAS float* sm_rstd = sm + 128; LAS float* sm_part = sm + 256;
    if (tid < 128) {
        float mean = 0.f, rstd = 0.f;
        if (tid < nj) { const float s1 = vstat[2 * (row0 + tid)], s2 = vstat[2 * (row0 + tid) + 1]; mean = s1 * (1.0f / CC); const float var = fmaxf(s2 * (1.0f / CC) - mean * mean, 0.f); rstd = rsqrtf(var + EPS); }
        sm_mean[tid] = mean; sm_rstd[tid] = rstd;
    }
    __syncthreads();
    if (sample && GV) {
        float* gv = GV + (size_t)(row0 - MP + i0) * CC;
        for (int e = tid; e < 16 * 384; e += NTHREADS) {
            const int r = e / 384, c4 = (e - r * 384) * 4;
            f32x4 v = *(f32x4*)(gv + (size_t)r * CC + c4); const f32x4 gg = *(const f32x4*)(lvg + c4), bb = *(const f32x4*)(lvb + c4);
            const float mean = sm_mean[i0 + r], rstd = sm_rstd[i0 + r];
            v = (v - mean) * rstd * gg + bb;
            *(f32x4*)(gv + (size_t)r * CC + c4) = v;
        }
    }
    const int h = wave >> 1, cw0 = 192 * wave, l15 = lane & 15, g = lane >> 4;
    const int i = i0 + l15;
    bf16x8 wf[4]; float c1 = 0.f, c2 = 0.f;
    {
        const float* wrow = Ws + ((size_t)h * 128 + i) * 128;
#pragma unroll
        for (int ks = 0; ks < 4; ++ks) {
            u32x4 w = (u32x4){0u, 0u, 0u, 0u};
            if (ks < nks) {
                const int j0 = 32 * ks + 8 * g; const f32x4 w0 = *(const f32x4*)(wrow + j0), w1 = *(const f32x4*)(wrow + j0 + 4);
                const f32x4 r0 = *(const LAS f32x4*)(sm_rstd + j0), r1 = *(const LAS f32x4*)(sm_rstd + j0 + 4), m0 = *(const LAS f32x4*)(sm_mean + j0), m1 = *(const LAS f32x4*)(sm_mean + j0 + 4);
                float wv[8] = {w0[0], w0[1], w0[2], w0[3], w1[0], w1[1], w1[2], w1[3]};
                const float rv[8] = {r0[0], r0[1], r0[2], r0[3], r1[0], r1[1], r1[2], r1[3]}, mv[8] = {m0[0], m0[1], m0[2], m0[3], m1[0], m1[1], m1[2], m1[3]};
#pragma unroll
                for (int e = 0; e < 8; ++e) { const int j = j0 + e; const float wm = (j <= i) ? wv[e] : 0.f; const float wp = wm * rv[e]; c1 += wp * mv[e]; c2 += wm; wv[e] = wp; }
                w.x = cvt_pk_bf16(wv[0], wv[1]); w.y = cvt_pk_bf16(wv[2], wv[3]); w.z = cvt_pk_bf16(wv[4], wv[5]); w.w = cvt_pk_bf16(wv[6], wv[7]);
            }
            wf[ks] = __builtin_bit_cast(bf16x8, w);
        }
        c1 += __shfl_xor(c1, 16); c1 += __shfl_xor(c1, 32); c2 += __shfl_xor(c2, 16); c2 += __shfl_xor(c2, 32);
    }
    f32x4 z[12];
#pragma unroll
    for (int nt = 0; nt < 12; ++nt) z[nt] = (f32x4){0.f, 0.f, 0.f, 0.f};
#pragma unroll
    for (int nt = 0; nt < 12; ++nt) {
        const bf16_t* vp = VT + (size_t)(cw0 + 16 * nt + l15) * MT + row0 + 8 * g;
#pragma unroll
        for (int ks = 0; ks < 4; ++ks) if (ks < nks) {
            const bf16x8 vf = *(const bf16x8*)(vp + 32 * ks);
            z[nt] = __builtin_amdgcn_mfma_f32_16x16x32_bf16(vf, wf[ks], z[nt], 0, 0, 0);
        }
    }
    const float bs = bsp[h * 128 + i];
    const int row = row0 + i;
    float ss = 0.f;
#pragma unroll
    for (int nt = 0; nt < 12; ++nt) {
        const int c = cw0 + 16 * nt + 4 * g; const f32x4 gv = *(const f32x4*)(lvg + c), bv = *(const f32x4*)(lvb + c);
        const u32x2 ug = *(const u32x2*)(P + (size_t)row * PW + P_UG + c);
        const float uu[4] = {bflo(ug.x), bfhi(ug.x), bflo(ug.y), bfhi(ug.y)};
        f32x4 y;
#pragma unroll
        for (int j = 0; j < 4; ++j) { const float zz = gv[j] * (z[nt][j] - c1) + bv[j] * c2 + bs; y[j] = uu[j] * zz; }
        z[nt] = y; ss += (y[0] * y[0] + y[1] * y[1]) + (y[2] * y[2] + y[3] * y[3]);
    }
    ss += __shfl_xor(ss, 16); ss += __shfl_xor(ss, 32);
    if (g == 0) sm_part[wave * 16 + l15] = ss;
    __syncthreads();
    {
        float tot = 0.f;
#pragma unroll
        for (int w = 0; w < 8; ++w) tot += sm_part[w * 16 + l15];
        const float rs = rsqrtf(tot * (1.0f / CC) + EPS);
#pragma unroll
        for (int nt = 0; nt < 12; ++nt) {
            const int c = cw0 + 16 * nt + 4 * g; const f32x4 gb = *(const f32x4*)(g_branch + CC + c);
            const f32x4 y = z[nt] * rs * gb;
            u32x2 w; w.x = cvt_pk_bf16(y[0], y[1]); w.y = cvt_pk_bf16(y[2], y[3]);
            *(u32x2*)(MIX + (size_t)row * DM + CC + c) = w;
        }
    }
    __syncthreads();
}

__device__ __forceinline__ void conv_unit(int a, const bf16_t* P, const bf16_t* GLU, const float* cw, const float* cb,
                                          const float* lg, const float* lb, const float* g_branch, bf16_t* MIX,
                                          LAS float* cbuf, int tid, int wave, int lane) {
    const int row0 = 16 * a;
    const bf16_t* gbase = GLU + (size_t)(glu_row(row0) - 30) * CC;
    const __amdgpu_buffer_rsrc_t rx = __builtin_amdgcn_make_buffer_rsrc((void*)gbase, 0, 46 * CC * 2, 0x00020000);
    const __amdgpu_buffer_rsrc_t rw = __builtin_amdgcn_make_buffer_rsrc((void*)cw, 0, 31 * CC * 4, 0x00020000);
#pragma unroll 1
    for (int it = 0; it < 2; ++it) {
        const int cp = tid + 512 * it;
        if (cp < CC / 2) {
            float w[31][2];
#pragma unroll
            for (int j = 0; j < 31; ++j) { w[j][0] = __builtin_bit_cast(float, __builtin_amdgcn_raw_buffer_load_b32(rw, cp * 8, j * CC * 4, 0)); w[j][1] = __builtin_bit_cast(float, __builtin_amdgcn_raw_buffer_load_b32(rw, cp * 8 + 4, j * CC * 4, 0)); }
            float acc[16][2];
            const float b0 = cb[2 * cp], b1 = cb[2 * cp + 1];
#pragma unroll
            for (int tt = 0; tt < 16; ++tt) { acc[tt][0] = b0; acc[tt][1] = b1; }
#pragma unroll
            for (int r = 0; r < 46; ++r) {
                const unsigned xv = (unsigned)__builtin_amdgcn_raw_buffer_load_b32(rx, cp * 4, r * CC * 2, 0);
                const float x0 = bflo(xv), x1 = bfhi(xv);
#pragma unroll
                for (int tt = 0; tt < 16; ++tt) if (r - tt >= 0 && r - tt <= 30) { acc[tt][0] += w[r - tt][0] * x0; acc[tt][1] += w[r - tt][1] * x1; }
            }
#pragma unroll
            for (int tt = 0; tt < 16; ++tt) { LAS float* d = cbuf + tt * CC + 2 * cp; d[0] = acc[tt][0]; d[1] = acc[tt][1]; }
        }
    }
    __syncthreads();
#pragma unroll
    for (int ti = 0; ti < 2; ++ti) {
        const int tt = 2 * wave + ti, row = row0 + tt;
        f32x4 v[6]; float s1 = 0.f, s2 = 0.f;
#pragma unroll
        for (int i = 0; i < 6; ++i) { v[i] = *(const LAS f32x4*)(cbuf + tt * CC + 4 * lane + 256 * i);
            s1 += (v[i][0] + v[i][1]) + (v[i][2] + v[i][3]); s2 += (v[i][0] * v[i][0] + v[i][1] * v[i][1]) + (v[i][2] * v[i][2] + v[i][3] * v[i][3]); }
        s1 = wave_sum(s1); s2 = wave_sum(s2);
        const float mean = s1 * (1.0f / CC), var = fmaxf(s2 * (1.0f / CC) - mean * mean, 0.f), rstd = rsqrtf(var + EPS);
        float q = 0.f;
#pragma unroll
        for (int i = 0; i < 6; ++i) {
            const int c = 4 * lane + 256 * i;
            const f32x4 gg = *(const f32x4*)(lg + c), bb = *(const f32x4*)(lb + c);
            const u32x2 sg = *(const u32x2*)(P + (size_t)row * PW + P_SGC + c);
            const float sv[4] = {bflo(sg.x), bfhi(sg.x), bflo(sg.y), bfhi(sg.y)};
#pragma unroll
            for (int j = 0; j < 4; ++j) { float y = (v[i][j] - mean) * rstd * gg[j] + bb[j]; y = y * sigmoidf_(y) * sv[j]; v[i][j] = y; q += y * y; }
        }
        q = wave_sum(q);
        const float rs = rsqrtf(q * (1.0f / CC) + EPS);
#pragma unroll
        for (int i = 0; i < 6; ++i) {
            const int c = 4 * lane + 256 * i;
            const f32x4 gb = *(const f32x4*)(g_branch + c);
            const f32x4 y = v[i] * rs * gb;
            u32x2 o; o.x = cvt_pk_bf16(y[0], y[1]); o.y = cvt_pk_bf16(y[2], y[3]);
            *(u32x2*)(MIX + (size_t)row * DM + c) = o;
        }
    }
    __syncthreads();
}

__global__ void __launch_bounds__(NTHREADS, 2) mega_fwd(Args args) {
    extern __shared__ __attribute__((aligned(16))) unsigned char lds_raw[];
    LAS unsigned char* lds = (LAS unsigned char*)lds_raw;
    cg::grid_group grid = cg::this_grid();
    const int tid = threadIdx.x, lane = tid & 63, wave = __builtin_amdgcn_readfirstlane(tid >> 6);
    const int G = gridDim.x, bx = blockIdx.x;
    unsigned char* ws = args.ws;
    float* out = args.out;
    const float* x_prompt = args.in[0]; const float* x_sample = args.in[1]; const float* mem_prompt = args.in[2];
    const float* cache_k = args.in[3]; const float* cache_v = args.in[4]; const float* cache_conv = args.in[5];
    const float* g_pre = args.in[6]; const float* w_in = args.in[7]; const float* conv_w = args.in[8]; const float* conv_b = args.in[9];
    const float* ln_conv_g = args.in[10]; const float* ln_conv_b = args.in[11]; const float* ln_v_g = args.in[12]; const float* ln_v_b = args.in[13];
    const float* w_spatial = args.in[14]; const float* b_spatial = args.in[15]; const float* g_mem = args.in[16]; const float* w_mk = args.in[17]; const float* w_mv = args.in[18];
    const float* g_branch = args.in[19]; const float* w_out = args.in[20]; const float* g_post = args.in[21];
    unsigned* ctl = (unsigned*)(ws + WS_CTL);
    volatile LAS unsigned* bst = (volatile LAS unsigned*)(lds + LDS_BYTES - 16);
    if (tid < 4) bst[tid] = 0u;
    __syncthreads();
    const XcdBarrier xbar = xcd_barrier_post((unsigned*)(ws + CTL_BAR), bst);
    float* vstat = (float*)(ws + CTL_VSTAT); float* oss = (float*)(ws + CTL_OSS);
    bf16_t* WT = (bf16_t*)(ws + WS_WT); bf16_t* WO = (bf16_t*)(ws + WS_WO); bf16_t* H = (bf16_t*)(ws + WS_H); bf16_t* PB = (bf16_t*)(ws + WS_P);
    bf16_t* VT = (bf16_t*)(ws + WS_VT); bf16_t* KB = (bf16_t*)(ws + WS_KB); bf16_t* VTM = (bf16_t*)(ws + WS_VTM); bf16_t* MIX = (bf16_t*)(ws + WS_MIX); bf16_t* OB = (bf16_t*)(ws + WS_OUT); bf16_t* GLU = (bf16_t*)(ws + WS_GLU); bf16_t* QF = (bf16_t*)(ws + WS_QF); bf16_t* OF = (bf16_t*)(ws + WS_OF);

#ifndef REP_P0
#define REP_P0 1
#endif
#ifndef REP_P2
#define REP_P2 1
#endif
#ifndef REP_P4
#define REP_P4 1
#endif
    for (int rep0 = 0; rep0 < REP_P0; ++rep0) {
        const int gw = bx * 8 + wave, NGW = G * 8;
        LAS float* scr = (LAS float*)(lds + wave * 16640);
        constexpr int I_IN = 64 * 176, I_MK = 64 * 16, I_CV = 16 * 64, NITEMS = I_IN + 2 * I_MK + I_CV;
        for (int it = gw; it < NITEMS; it += NGW) {
            int r = it;
            if (r < I_IN) { const int kb = r / 176, nb = r - kb * 176; transpose_item64(w_in, NIN, WT, DM, 64 * kb, 64 * nb, win_dest_row(64 * nb) - 64 * nb, scr, lane); continue; } r -= I_IN;
            if (r < I_MK) { const int kb = r >> 4, nb = r & 15; transpose_item64(w_mk, CX, WT, DM, 64 * kb, 64 * nb, NIN, scr, lane); continue; } r -= I_MK;
            if (r < I_MK) { const int kb = r >> 4, nb = r & 15; transpose_item64(w_mv, CX, WT, DM, 64 * kb, 64 * nb, NIN + CX, scr, lane); continue; } r -= I_MK;
            { const int b = r >> 6, q = r & 63, kb = q >> 4, nb = q & 15; transpose_item64(cache_v + (size_t)b * 256 * 1024, 1024, VTM + (size_t)(2 + b) * 1024 * 256, 256, 64 * kb, 64 * nb, 0, scr, lane); }
        }
        for (int m = gw; m < MT + MEMR; m += NGW) {
            const float* src; const float* gg;
            if (m < MP) { src = x_prompt + (size_t)m * DM; gg = g_pre; } else if (m < MT) { src = x_sample + (size_t)(m - MP) * DM; gg = g_pre; } else { src = mem_prompt + (size_t)(m - MT) * DM; gg = g_mem; }
            rms_row_bf16(src, gg, H + (size_t)m * DM, lane);
        }
        for (int i = gw * 64 + lane; i < 16 * 256 * 1024 / 4; i += NGW * 64) {
            const f32x4 v = ((const f32x4*)cache_k)[i];
            u32x2 o; o.x = cvt_pk_bf16(v[0], v[1]); o.y = cvt_pk_bf16(v[2], v[3]);
            ((u32x2*)(KB + (size_t)2 * 256 * 1024))[i] = o;
        }
        for (int i = gw * 64 + lane; i < 18 * 30 * CC / 4; i += NGW * 64) {
            const int hr = i / (CC / 4), c4 = i - hr * (CC / 4), b = hr / 30, r = hr - b * 30;
            u32x2 o = (u32x2){0u, 0u};
            if (b >= 2) { const f32x4 v = ((const f32x4*)cache_conv)[i - 2 * 30 * CC / 4]; o.x = cvt_pk_bf16(v[0], v[1]); o.y = cvt_pk_bf16(v[2], v[3]); }
            const int grow = (b < 2 ? b * 4126 : 8252 + (b - 2) * 94) + r;
            ((u32x2*)(GLU + (size_t)grow * CC))[c4] = o;
        }
    }
    if (gridDim.y == 0x7fffu) grid.sync();
    xcd_barrier(xbar);

    {
#ifndef NO_G1
        { pg8::Gemm g{H, WT, DM}; Sched1 S{bx}; EpiMix<Epi1> E{Epi1{PB, GLU, VT, vstat, out, KB, VTM}, EpiSlab{QF, CX, 0, 36, SLAB}};
          pg8::gemm_phase<EpiMix<Epi1>, Sched1>(lds, g, S, E); }
#endif
    }
    xcd_barrier(xbar);

    for (int rep2 = 0; rep2 < REP_P2; ++rep2) {
        LAS float* cbuf = (LAS float*)lds;
        LAS float* sm = (LAS float*)(lds + 135168);
        LAS int* sm_next = (LAS int*)(lds + 135168 + 4096);
        constexpr int NA = 80, NC = 576, NB = 576, NW = 512, NU = NA + NC + NB + NW;
        for (;;) {
            if (tid == 0) *sm_next = (int)atomicAdd(ctl + 64 * rep2, 1u);
            __syncthreads();
            const int u = __builtin_amdgcn_readfirstlane(*sm_next);
            __syncthreads();
            if (u >= NU) break;
            int tidv = tid, wv = wave;
            asm volatile("" : "+v"(tidv), "+s"(wv));
            tidv &= 511; wv &= 7;
            const int lanev = tidv & 63;
#ifndef P2_MASK
#define P2_MASK 7
#endif
            const int pmask = rep2 == 0 ? 7 : P2_MASK;
            if (u >= NA + NC + NB) {
                const int it = 8 * (u - NA - NC - NB) + wv;
                transpose_item64(w_out, DM, WO, DM, 64 * (it >> 6), 64 * (it & 63), 0, (LAS float*)(lds + wv * 16640), lanev);
                __syncthreads();
            } else if (u < NA) {
                if (pmask & 1) {
#ifndef NO_ATTN
                attn_unit(u, PB, QF, KB, VTM, g_branch, MIX, lds, tidv, wv, lanev);
#endif
                }
            } else if (u < NA + NC) {
                if (pmask & 2) {
#ifndef NO_CONV
                conv_unit(u - NA, PB, GLU, conv_w, conv_b, ln_conv_g, ln_conv_b, g_branch, MIX, cbuf, tidv, wv, lanev);
#endif
                }
            } else {
                if (pmask & 4) {
#ifndef NO_GMLP
                gmlp_unit(u - NA - NC, PB, VT, vstat, w_spatial, b_spatial, ln_v_g, ln_v_b, g_branch, rep2 == 0 ? out + O_GV : nullptr, MIX, sm, tidv, wv, lanev);
#endif
                }
            }
        }
    }
    xcd_barrier(xbar);

    {
#ifndef NO_G2
        { pg8::Gemm g{MIX, WO, DM}; Sched2 S{bx}; EpiMix<Epi2F> E{Epi2F{x_prompt, g_post, out + O_Y, oss, (unsigned*)(ws + CTL_PCNT)}, EpiSlab{OF, DM, 32, 0, SLAB}};
          pg8::gemm_phase<EpiMix<Epi2F>, Sched2>(lds, g, S, E); }
#endif
    }
    xcd_barrier(xbar);

    for (int rep4 = 0; rep4 < REP_P4; ++rep4) {
        const int lane = opq(tid) & 63;
        const int gw = bx * 8 + wave, NGW = G * 8;
        for (int m = MP + gw; m < MT; m += NGW) {
            float* yr = out + O_Y + (size_t)m * DM;
            if (m < MP) {
                const float* xr = x_prompt + (size_t)m * DM; const bf16_t* orow = OB + (size_t)m * DM;
                u32x4 ov[8]; f32x4 xv[16]; float q = 0.f;
#pragma unroll
                for (int j = 0; j < 8; ++j) ov[j] = *(const u32x4*)(orow + (lane + 64 * j) * 8);
#pragma unroll
                for (int j = 0; j < 8; ++j) { xv[2 * j] = *(const f32x4*)(xr + (lane + 64 * j) * 8); xv[2 * j + 1] = *(const f32x4*)(xr + (lane + 64 * j) * 8 + 4); }
#pragma unroll
                for (int j = 0; j < 8; ++j) {
                    const float a0 = bflo(ov[j].x), a1 = bfhi(ov[j].x), a2 = bflo(ov[j].y), a3 = bfhi(ov[j].y), a4 = bflo(ov[j].z), a5 = bfhi(ov[j].z), a6 = bflo(ov[j].w), a7 = bfhi(ov[j].w);
                    q += (a0 * a0 + a1 * a1) + (a2 * a2 + a3 * a3) + (a4 * a4 + a5 * a5) + (a6 * a6 + a7 * a7); }
                q = wave_sum(q);
                const float rs = rsqrtf(q * (1.0f / DM) + EPS);
#pragma unroll
                for (int j = 0; j < 8; ++j) {
                    const int c = (lane + 64 * j) * 8;
                    const f32x4 x0 = xv[2 * j], x1 = xv[2 * j + 1], g0 = *(const f32x4*)(g_post + c), g1 = *(const f32x4*)(g_post + c + 4);
                    f32x4 y0, y1;
                    y0[0] = x0[0] + bflo(ov[j].x) * rs * g0[0]; y0[1] = x0[1] + bfhi(ov[j].x) * rs * g0[1]; y0[2] = x0[2] + bflo(ov[j].y) * rs * g0[2]; y0[3] = x0[3] + bfhi(ov[j].y) * rs * g0[3];
                    y1[0] = x1[0] + bflo(ov[j].z) * rs * g1[0]; y1[1] = x1[1] + bfhi(ov[j].z) * rs * g1[1]; y1[2] = x1[2] + bflo(ov[j].w) * rs * g1[2]; y1[3] = x1[3] + bfhi(ov[j].w) * rs * g1[3];
                    *(f32x4*)(yr + c) = y0; *(f32x4*)(yr + c + 4) = y1;
                }
            } else {
                const float* xr = x_sample + (size_t)(m - MP) * DM; const bf16_t* orow = OF + (size_t)(m - MP) * DM;
                f32x4 ov[16]; float q = 0.f;
#pragma unroll
                for (int j = 0; j < 16; ++j) { const bf16_t* op = orow + (lane + 64 * j) * 4;
                    const u32x2 p0 = *(const u32x2*)op, p1 = *(const u32x2*)(op + SLAB), p2 = *(const u32x2*)(op + 2 * SLAB), p3 = *(const u32x2*)(op + 3 * SLAB);
                    ov[j][0] = (bflo(p0.x) + bflo(p1.x)) + (bflo(p2.x) + bflo(p3.x)); ov[j][1] = (bfhi(p0.x) + bfhi(p1.x)) + (bfhi(p2.x) + bfhi(p3.x));
                    ov[j][2] = (bflo(p0.y) + bflo(p1.y)) + (bflo(p2.y) + bflo(p3.y)); ov[j][3] = (bfhi(p0.y) + bfhi(p1.y)) + (bfhi(p2.y) + bfhi(p3.y));
                    q += (ov[j][0] * ov[j][0] + ov[j][1] * ov[j][1]) + (ov[j][2] * ov[j][2] + ov[j][3] * ov[j][3]); }
                q = wave_sum(q);
                const float rs = rsqrtf(q * (1.0f / DM) + EPS);
#pragma unroll
                for (int j = 0; j < 16; ++j) {
                    const int c = (lane + 64 * j) * 4;
                    const f32x4 x0 = *(const f32x4*)(xr + c), g0 = *(const f32x4*)(g_post + c);
                    *(f32x4*)(yr + c) = x0 + ov[j] * rs * g0;
                }
            }
        }
    }
}

extern "C" void kernel_launch(void* const* d_in, const int* in_sizes, int n_in, void* d_out, int out_size, void* d_ws, size_t ws_size, hipStream_t stream) {
    static int grid = 0;
    if (grid == 0) {
        if (n_in != 22 || ws_size < WS_END) { fprintf(stderr, "kernel_launch: unexpected inputs (n_in %d, ws %zu)\n", n_in, ws_size); grid = -1; return; }
        int dev = 0, cus = 0, per_cu = 0;
        (void)hipGetDevice(&dev);
        (void)hipDeviceGetAttribute(&cus, hipDeviceAttributeMultiprocessorCount, dev);
        if (hipFuncSetAttribute((const void*)mega_fwd, hipFuncAttributeMaxDynamicSharedMemorySize, LDS_BYTES) != hipSuccess) { fprintf(stderr, "kernel_launch: hipFuncSetAttribute failed\n"); grid = -1; return; }
        if (hipOccupancyMaxActiveBlocksPerMultiprocessor(&per_cu, (const void*)mega_fwd, NTHREADS, LDS_BYTES) != hipSuccess || per_cu < 1) { fprintf(stderr, "kernel_launch: occupancy query says %d\n", per_cu); per_cu = 1; }
        (void)hipGetLastError();
        grid = 256;
        if (cus != 256) fprintf(stderr, "kernel_launch: built for a 256-CU device, found %d CUs\n", cus);
    }
    if (grid < 0) return;
    (void)hipMemsetAsync((char*)d_ws + WS_CTL, 0, CTL_BYTES, stream);
    Args a{};
    for (int i = 0; i < 22; ++i) a.in[i] = (const float*)d_in[i];
    a.out = (float*)d_out; a.ws = (unsigned char*)d_ws;
    void* kargs[] = {&a};
    hipError_t e = hipLaunchCooperativeKernel((const void*)mega_fwd, dim3(grid), dim3(NTHREADS), kargs, LDS_BYTES, stream);
    if (e != hipSuccess) fprintf(stderr, "kernel_launch: cooperative launch failed: %s (grid %d)\n", hipGetErrorString(e), grid);
}
```

```cpp
#include <hip/hip_runtime.h>
#include <hip/hip_cooperative_groups.h>
#include <cstdio>
#include <cstdint>
namespace cg = cooperative_groups;

#define LAS __attribute__((address_space(3)))
typedef unsigned short bf16_t;
typedef short bf16x8 __attribute__((ext_vector_type(8)));
typedef short s16x4 __attribute__((ext_vector_type(4)));
typedef float f32x4 __attribute__((ext_vector_type(4)));
typedef unsigned u32x4 __attribute__((ext_vector_type(4)));
typedef unsigned u32x2 __attribute__((ext_vector_type(2)));

constexpr int DM = 4096;
constexpr int MP = 8192, MS = 1024, MT = MP + MS;
constexpr int NIN = 11264;
constexpr int CC = 1536;
constexpr int CX = 1024;
constexpr int MEMR = 512;
constexpr float EPS = 1e-6f;
constexpr int PW = 5120;
constexpr int P_UG = 0, P_SGC = 1536, P_Q = 3072, P_SGX = 4096;
constexpr int GROWS = MT + 18 * 30;
__device__ __forceinline__ int glu_row(int row) { return row < MP ? row + 30 * ((row >> 12) + 1) : row + 30 * (((row - MP) >> 6) + 3); }
constexpr float QSCALE = 0.0625f * 1.4426950408889634f;

constexpr size_t O_Y = 0, O_MK = (size_t)MT * DM, O_MV = O_MK + 524288, O_CP = O_MV + 524288, O_CS = O_CP + 92160, O_GV = O_CS + 737280;

constexpr size_t MiB = 1u << 20;
constexpr size_t WS_CTL = 0, CTL_BYTES = 262144;
constexpr size_t CTL_BAR = 131072;
constexpr size_t CTL_PCNT = 196608;
constexpr size_t CTL_VSTAT = 4096, CTL_OSS = CTL_VSTAT + (size_t)MT * 8;
static_assert(CTL_OSS + (size_t)MT * 4 <= CTL_BYTES, "ctl");
constexpr size_t WS_WT = 2 * MiB;
constexpr size_t WS_WO = 106 * MiB;
constexpr size_t WS_H = 138 * MiB;
constexpr size_t WS_P = 214 * MiB;
constexpr size_t WS_VT = 332 * MiB;
constexpr size_t WS_KB = 360 * MiB;
constexpr size_t WS_VTM = 370 * MiB;
constexpr size_t WS_MIX = 380 * MiB;
constexpr size_t WS_OUT = 452 * MiB;
constexpr size_t WS_GLU = 524 * MiB;
constexpr size_t WS_QF = 556 * MiB;
constexpr size_t WS_OF = 620 * MiB;
constexpr size_t WS_END = 684 * MiB;
constexpr size_t SLAB = (size_t)4096 * 1024;
static_assert(WS_GLU + (size_t)GROWS * CC * 2 <= WS_END, "glu");
static_assert(WS_WT + (size_t)13312 * 4096 * 2 <= WS_WO && WS_WO + (size_t)4096 * 4096 * 2 <= WS_H && WS_H + (size_t)9728 * 4096 * 2 <= WS_P &&
              WS_P + (size_t)MT * PW * 2 <= WS_VT && WS_VT + (size_t)CC * MT * 2 <= WS_KB && WS_KB + (size_t)18 * 256 * 1024 * 2 <= WS_VTM &&
              WS_VTM + (size_t)18 * 1024 * 256 * 2 <= WS_MIX && WS_MIX + (size_t)MT * DM * 2 <= WS_OUT && WS_OUT + (size_t)MT * DM * 2 <= WS_END, "ws map");

constexpr int LDS_BYTES = 143360;
constexpr int NTHREADS = 512;

__device__ __forceinline__ unsigned cvt_pk_bf16(float lo, float hi) { unsigned r; asm volatile("v_cvt_pk_bf16_f32 %0, %1, %2" : "=v"(r) : "v"(lo), "v"(hi)); return r; }
__device__ __forceinline__ bf16_t f2bf(float f) { return (bf16_t)(cvt_pk_bf16(f, 0.f) & 0xffffu); }
__device__ __forceinline__ float bf2f(bf16_t u) { return __uint_as_float(((unsigned)u) << 16); }
__device__ __forceinline__ float bflo(unsigned u) { return __uint_as_float(u << 16); }
__device__ __forceinline__ float bfhi(unsigned u) { return __uint_as_float(u & 0xffff0000u); }
__device__ __forceinline__ float sigmoidf_(float x) { return __builtin_amdgcn_rcpf(1.0f + __builtin_amdgcn_exp2f(-1.4426950408889634f * x)); }
__device__ __forceinline__ float wave_sum(float v) {
#pragma unroll
    for (int o = 1; o < 64; o <<= 1) v += __shfl_xor(v, o);
    return v;
}
#define LDS_WAIT() asm volatile("s_waitcnt lgkmcnt(0)" ::: "memory")
__device__ __forceinline__ int opq(int x) { asm volatile("" : "+v"(x)); return x; }

namespace pg8 {
constexpr int BM = 256, BK = 64, HALF = 128, HTB = HALF * BK * 2, STAGE_BYTES = 8 * HTB;
__device__ __forceinline__ int lds_byte(int r, int c) { const int st = (r >> 4) * 2 + (c >> 5), rr = r & 15, cc = c & 31, ob = rr * 64 + cc * 2; return st * 1024 + (ob ^ (((ob >> 9) & 1) << 5)); }
__device__ __forceinline__ void stage_rc(int b, int& R, int& C) { const int st = b / 1024, sb = b % 1024, swz = sb ^ (((sb >> 9) & 1) << 5); R = (st >> 1) * 16 + swz / 64; C = (st & 1) * 32 + (swz % 64) / 2; }
__device__ __forceinline__ int perm32(int rho) { const int n = rho >> 4, i = rho & 15; return 8 * (i >> 2) + 4 * n + (i & 3); }
struct Unit { int pm, pn, koff, kt; };
struct Gemm { const bf16_t* A; const bf16_t* Bt; int ld; };

template <class Epi, class Sched>
__device__ __forceinline__ void gemm_phase(LAS unsigned char* lds, const Gemm g, const Sched& S, const Epi& E) {
    const int tid = opq((int)threadIdx.x) & 511, wid = __builtin_amdgcn_readfirstlane(tid >> 6), lane = tid & 63, wr = wid >> 2, wc = wid & 3, fr = lane & 15, fq = lane >> 4;
    const int K = g.ld;
    unsigned voffA[2], voffB[2];
#pragma unroll
    for (int i = 0; i < 2; ++i) { int R, C; stage_rc(tid * 16 + i * 8192, R, C); const int Rb = (R & ~31) + perm32(R & 31);
        voffA[i] = (unsigned)(R * K + C) * 2u; voffB[i] = (unsigned)(Rb * K + C) * 2u; }
    const size_t kstep = (size_t)(BK * 2);
    const size_t hstep = (size_t)HALF * K * 2;
    const size_t tstep = 2 * hstep;
    const unsigned ldsw = (unsigned)wid * 1024u;
    const int aoff = lds_byte(wr * 64 + fr, fq * 8), boff = lds_byte(wc * 32 + fr, fq * 8);
#define PG8_SA(b, h) (((b) * 2 + (h)) * HTB)
#define PG8_SB(b, h) ((4 + (b) * 2 + (h)) * HTB)
#define PG8_STAGE(bufoff, gbase, voff) do { _Pragma("unroll") for (int _i = 0; _i < 2; ++_i) \
        __builtin_amdgcn_global_load_lds((const unsigned*)((const char*)(gbase) + (voff)[_i]), (LAS unsigned*)(lds + (bufoff) + ldsw + _i * 8192), 16, 0, 0); } while (0)
#define PG8_LDA(dst, b, h) do { _Pragma("unroll") for (int m = 0; m < 4; ++m) _Pragma("unroll") for (int k = 0; k < 2; ++k) dst[m][k] = *(const LAS bf16x8*)(lds + PG8_SA(b, h) + aoff + m * 2048 + k * 1024); } while (0)
#define PG8_LDB(dst, b, h) do { _Pragma("unroll") for (int n = 0; n < 2; ++n) _Pragma("unroll") for (int k = 0; k < 2; ++k) dst[n][k] = *(const LAS bf16x8*)(lds + PG8_SB(b, h) + boff + n * 2048 + k * 1024); } while (0)
#define PG8_MMA(ai, bj, At, Bt) do { __builtin_amdgcn_s_setprio(1); _Pragma("unroll") for (int m = 0; m < 4; ++m) _Pragma("unroll") for (int n = 0; n < 2; ++n) _Pragma("unroll") for (int k = 0; k < 2; ++k) \
        acc[ai][bj][m][n] = __builtin_amdgcn_mfma_f32_16x16x32_bf16(Bt[n][k], At[m][k], acc[ai][bj][m][n], 0, 0, 0); __builtin_amdgcn_s_setprio(0); } while (0)
#define PG8_WAIT_V(n) asm volatile("s_waitcnt vmcnt(" #n ")" ::: "memory")
#define PG8_WAIT_L(n) asm volatile("s_waitcnt lgkmcnt(" #n ")" ::: "memory")
#define PG8_BAR __builtin_amdgcn_s_barrier()
#define PG8_SCHED __builtin_amdgcn_sched_barrier(0)
    Unit cur, nxt; int ui = 0;
    if (!S.next(0, cur)) return;
    f32x4 acc[2][2][4][2];
#pragma unroll
    for (int a = 0; a < 2; ++a)
#pragma unroll
        for (int b = 0; b < 2; ++b)
#pragma unroll
            for (int m = 0; m < 4; ++m)
#pragma unroll
                for (int n = 0; n < 2; ++n) acc[a][b][m][n] = (f32x4){0.f, 0.f, 0.f, 0.f};
    bf16x8 At[4][2], B0[2][2], B1[2][2];
    const char* cA = (const char*)g.A + (size_t)cur.pm * tstep + (size_t)cur.koff * 2; const char* cB = (const char*)g.Bt + (size_t)cur.pn * tstep + (size_t)cur.koff * 2;
    PG8_STAGE(PG8_SB(0, 0), cB, voffB); PG8_STAGE(PG8_SB(0, 1), cB + hstep, voffB); PG8_STAGE(PG8_SA(0, 0), cA, voffA); PG8_STAGE(PG8_SA(0, 1), cA + hstep, voffA);
    if (wr == 1) PG8_BAR;
    PG8_WAIT_V(2); PG8_BAR;
    PG8_STAGE(PG8_SB(1, 0), cB + kstep, voffB); PG8_STAGE(PG8_SA(1, 0), cA + kstep, voffA); PG8_STAGE(PG8_SB(1, 1), cB + hstep + kstep, voffB);
    PG8_WAIT_V(6); PG8_BAR;
    for (;;) {
        const bool has_next = S.next(ui + 1, nxt);
        const char* nA = has_next ? (const char*)g.A + (size_t)nxt.pm * tstep + (size_t)nxt.koff * 2 : cA; const char* nB = has_next ? (const char*)g.Bt + (size_t)nxt.pn * tstep + (size_t)nxt.koff * 2 : cB;
        const int nt = cur.kt;
        for (int t = 0; t < nt; t += 2) {
            const bool last = (t == nt - 2);
            const char* a1 = cA + (size_t)(t + 1) * kstep;
            const char* a2 = last ? nA : cA + (size_t)(t + 2) * kstep; const char* b2 = last ? nB : cB + (size_t)(t + 2) * kstep;
            const char* a3 = a2 + kstep; const char* b3 = b2 + kstep;
            PG8_LDB(B0, 0, 0); PG8_LDB(B1, 0, 1); PG8_SCHED; PG8_LDA(At, 0, 0); PG8_STAGE(PG8_SA(1, 1), a1 + hstep, voffA);
            PG8_WAIT_V(8); PG8_WAIT_L(0); PG8_BAR; PG8_MMA(0, 0, At, B0); PG8_MMA(0, 1, At, B1); PG8_BAR; PG8_SCHED;
            PG8_LDA(At, 0, 1); PG8_STAGE(PG8_SB(0, 0), b2, voffB); PG8_STAGE(PG8_SB(0, 1), b2 + hstep, voffB); PG8_STAGE(PG8_SA(0, 0), a2, voffA);
            PG8_WAIT_V(8); PG8_WAIT_L(0); PG8_BAR; PG8_MMA(1, 0, At, B0); PG8_MMA(1, 1, At, B1); PG8_BAR; PG8_SCHED;
            PG8_LDB(B0, 1, 0); PG8_LDB(B1, 1, 1); PG8_SCHED; PG8_LDA(At, 1, 0); PG8_STAGE(PG8_SA(0, 1), a2 + hstep, voffA);
            PG8_WAIT_V(8); PG8_WAIT_L(0); PG8_BAR; PG8_MMA(0, 0, At, B0); PG8_MMA(0, 1, At, B1); PG8_BAR; PG8_SCHED;
            PG8_LDA(At, 1, 1); PG8_STAGE(PG8_SB(1, 0), b3, voffB); PG8_STAGE(PG8_SB(1, 1), b3 + hstep, voffB); PG8_STAGE(PG8_SA(1, 0), a3, voffA);
            PG8_WAIT_V(8); PG8_WAIT_L(0); PG8_BAR; PG8_MMA(1, 0, At, B0); PG8_MMA(1, 1, At, B1); PG8_BAR; PG8_SCHED;
        }
        if (wr == 0) PG8_BAR;
        E(acc, cur, wr, wc, fr, fq);
        if (!has_next) break;
#pragma unroll
        for (int a = 0; a < 2; ++a)
#pragma unroll
            for (int b = 0; b < 2; ++b)
#pragma unroll
                for (int m = 0; m < 4; ++m)
#pragma unroll
                    for (int n = 0; n < 2; ++n) acc[a][b][m][n] = (f32x4){0.f, 0.f, 0.f, 0.f};
        cur = nxt; cA = nA; cB = nB; ++ui;
        if (wr == 1) PG8_BAR;
    }
    PG8_WAIT_V(0);
    PG8_BAR;
#undef PG8_SA
#undef PG8_SB
#undef PG8_STAGE
#undef PG8_LDA
#undef PG8_LDB
#undef PG8_MMA
#undef PG8_WAIT_V
#undef PG8_WAIT_L
#undef PG8_BAR
#undef PG8_SCHED
}
}

__device__ __forceinline__ void static_unit(int L, int nM, int nN, pg8::Unit& u) {
    const int nwg = nM * nN;
    int wgid = L; { const int q = nwg / 8, r = nwg % 8, xcd = wgid % 8, off = wgid / 8; wgid = (xcd < r ? xcd * (q + 1) : r * (q + 1) + (xcd - r) * q) + off; }
    const int nig = 8 * nN, gid = wgid / nig, fm = gid * 8, gsz = (nM - fm) < 8 ? (nM - fm) : 8;
    u.pm = fm + ((wgid % nig) % gsz); u.pn = (wgid % nig) / gsz; u.koff = 0; u.kt = 64;
}
__device__ __forceinline__ void g1_full_unit(int L, pg8::Unit& u) {
    pg8::Unit t; static_unit(L < 1440 ? L : 0, 36, 40, t); if (t.pn >= 36) t.pn += 4;
    const int r = L - 1440; const bool tail = L >= 1440, isq = r < 80;
    u.pm = tail ? (isq ? 16 + (r >> 2) : 36 + ((r - 80) >> 3)) : t.pm; u.pn = tail ? (isq ? 36 + (r & 3) : 44 + ((r - 80) & 7)) : t.pn; u.koff = 0; u.kt = 64;
}
struct Sched1 {
    int c;
    __device__ __forceinline__ bool next(int i, pg8::Unit& u) const {
        if (i >= 7) return false;
        const bool qfirst = (c & 4) != 0; const bool isq = (i == (qfirst ? 0 : 6));
        pg8::Unit f; g1_full_unit((qfirst ? (i > 0 ? i - 1 : 0) : (i < 6 ? i : 0)) * 256 + c, f);
        const int xcd = c & 7, j = c >> 3;
        u.pm = isq ? 2 * xcd + (j >> 4) : f.pm; u.pn = isq ? 36 + ((j & 15) >> 2) : f.pn; u.koff = isq ? 1024 * (j & 3) : 0; u.kt = isq ? 16 : 64;
        return true;
    }
};
struct Sched2 {
    int c;
    __device__ __forceinline__ bool next(int i, pg8::Unit& u) const {
        if (i >= 3) return false;
        const bool qfirst = (c & 4) != 0; const bool isq = (i == (qfirst ? 0 : 2));
        const int xcd = c & 7, j = c >> 3, r = qfirst ? i - 1 : i;
        u.pm = isq ? 32 + (xcd >> 1) : 16 * r + 2 * xcd + (j >> 4); u.pn = j & 15; u.koff = isq ? 1024 * (2 * (xcd & 1) + (j >> 4)) : 0; u.kt = isq ? 16 : 64;
        return true;
    }
};

struct Epi1 {
    bf16_t* P; bf16_t* GLU; bf16_t* VT; float* vstat; float* out; bf16_t* KB; bf16_t* VTM;
    __device__ __forceinline__ void operator()(const f32x4 (&acc)[2][2][4][2], const pg8::Unit& u, int wr, int wc, int fr, int fq) const {
        asm volatile("" : "+v"(fr), "+v"(fq));
        const int pm = u.pm, pn = u.pn;
        const int rb = pm * 256 + wr * 64 + fr;
        const int cl = wc * 32 + 8 * fq;
        if (pn < 24) {
            const bool isglu = pn < 12; const int t = isglu ? pn : pn - 12;
            bf16_t* base = (isglu ? GLU : P + P_UG) + t * 128 + cl;
#pragma unroll
            for (int ai = 0; ai < 2; ++ai)
#pragma unroll
                for (int m = 0; m < 4; ++m) {
                    const int row = rb + ai * 128 + m * 16;
                    f32x4 r0, r1; const f32x4 x0 = acc[ai][0][m][0], x1 = acc[ai][0][m][1], g0 = acc[ai][1][m][0], g1 = acc[ai][1][m][1];
#pragma unroll
                    for (int j = 0; j < 4; ++j) {
                        float s0 = sigmoidf_(g0[j]), s1 = sigmoidf_(g1[j]);
                        if (!isglu) { s0 *= g0[j]; s1 *= g1[j]; }
                        r0[j] = x0[j] * s0; r1[j] = x1[j] * s1;
                    }
                    u32x4 w; w.x = cvt_pk_bf16(r0[0], r0[1]); w.y = cvt_pk_bf16(r0[2], r0[3]); w.z = cvt_pk_bf16(r1[0], r1[1]); w.w = cvt_pk_bf16(r1[2], r1[3]);
                    *(u32x4*)(base + (isglu ? (size_t)glu_row(row) * CC : (size_t)row * PW)) = w;
                    if (isglu) {
                        float* dst = nullptr;
                        if (row < MP) { const int tt = row & 4095; if (tt >= 4066) dst = out + O_CP + ((size_t)(row >> 12) * 30 + (tt - 4066)) * CC; }
                        else { const int rr = row - MP, tt = rr & 63; if (tt >= 34) dst = out + O_CS + ((size_t)(rr >> 6) * 30 + (tt - 34)) * CC; }
                        if (dst) { dst += t * 128 + cl; *(f32x4*)dst = r0; *(f32x4*)(dst + 4) = r1; }
                    }
                }
        } else if (pn < 30 || (pn >= 36 && pn < 44)) {
            int cb; bool act = true;
            if (pn < 30) cb = P_SGC + (pn - 24) * 256; else if (pn < 40) { cb = P_Q + (pn - 36) * 256; act = false; } else cb = P_SGX + (pn - 40) * 256;
            bf16_t* base = P + cb + cl;
#pragma unroll
            for (int ai = 0; ai < 2; ++ai)
#pragma unroll
                for (int m = 0; m < 4; ++m) {
                    const int row = rb + ai * 128 + m * 16;
#pragma unroll
                    for (int bj = 0; bj < 2; ++bj) {
                        f32x4 v0 = acc[ai][bj][m][0], v1 = acc[ai][bj][m][1];
#pragma unroll
                        for (int j = 0; j < 4; ++j) {
                            if (act) { v0[j] *= sigmoidf_(v0[j]); v1[j] *= sigmoidf_(v1[j]); } else { v0[j] *= QSCALE; v1[j] *= QSCALE; }
                        }
                        u32x4 w; w.x = cvt_pk_bf16(v0[0], v0[1]); w.y = cvt_pk_bf16(v0[2], v0[3]); w.z = cvt_pk_bf16(v1[0], v1[1]); w.w = cvt_pk_bf16(v1[2], v1[3]);
                        *(u32x4*)(base + (size_t)row * PW + bj * 128) = w;
                    }
                }
        } else if (pn < 36) {
            const int c0 = (pn - 30) * 256 + cl;
#pragma unroll
            for (int ai = 0; ai < 2; ++ai)
#pragma unroll
                for (int m = 0; m < 4; ++m) {
                    const int row = rb + ai * 128 + m * 16;
                    float s = 0.f, q = 0.f;
#pragma unroll
                    for (int bj = 0; bj < 2; ++bj)
#pragma unroll
                        for (int n = 0; n < 2; ++n) {
                            const f32x4 v = acc[ai][bj][m][n];
#pragma unroll
                            for (int j = 0; j < 4; ++j) { s += v[j]; q += v[j] * v[j]; VT[(size_t)(c0 + bj * 128 + 4 * n + j) * MT + row] = f2bf(v[j]); }
                        }
                    s += __shfl_xor(s, 16); s += __shfl_xor(s, 32); q += __shfl_xor(q, 16); q += __shfl_xor(q, 32);
                    if (fq == 0) { atomicAdd(vstat + 2 * row, s); atomicAdd(vstat + 2 * row + 1, q); }
                    if (row >= MP) {
                        float* dst = out + O_GV + (size_t)(row - MP) * CC + c0;
#pragma unroll
                        for (int bj = 0; bj < 2; ++bj) { *(f32x4*)(dst + bj * 128) = acc[ai][bj][m][0]; *(f32x4*)(dst + bj * 128 + 4) = acc[ai][bj][m][1]; }
                    }
                }
        } else {
            const int b = pm - 36, hh = (pn - 44) & 3; const bool isv = pn >= 48;
            float* fo = out + (isv ? O_MV : O_MK);
#pragma unroll
            for (int ai = 0; ai < 2; ++ai)
#pragma unroll
                for (int m = 0; m < 4; ++m) {
                    const int mr = wr * 64 + fr + ai * 128 + m * 16;
                    const size_t rowg = (size_t)b * 256 + mr;
#pragma unroll
                    for (int bj = 0; bj < 2; ++bj) {
                        const f32x4 v0 = acc[ai][bj][m][0], v1 = acc[ai][bj][m][1];
                        const int d0 = bj * 128 + cl;
                        float* dst = fo + rowg * 1024 + hh * 256 + d0; *(f32x4*)dst = v0; *(f32x4*)(dst + 4) = v1;
                        if (!isv) {
                            u32x4 w; w.x = cvt_pk_bf16(v0[0], v0[1]); w.y = cvt_pk_bf16(v0[2], v0[3]); w.z = cvt_pk_bf16(v1[0], v1[1]); w.w = cvt_pk_bf16(v1[2], v1[3]);
                            *(u32x4*)(KB + rowg * 1024 + hh * 256 + d0) = w;
                        } else {
#pragma unroll
                            for (int j = 0; j < 4; ++j) { VTM[((size_t)(b * 4 + hh) * 256 + d0 + j) * 256 + mr] = f2bf(v0[j]); VTM[((size_t)(b * 4 + hh) * 256 + d0 + 4 + j) * 256 + mr] = f2bf(v1[j]); }
                        }
                    }
                }
        }
    }
};

struct Epi2F {
    const float* xp; const float* gpost; float* y; float* oss; unsigned* cnt;
    __device__ __forceinline__ void operator()(const f32x4 (&acc)[2][2][4][2], const pg8::Unit& u, int wr, int wc, int fr, int fq) const {
        asm volatile("" : "+v"(fr), "+v"(fq));
        const int rb = u.pm * 256 + wr * 64 + fr;
#pragma unroll
        for (int ai = 0; ai < 2; ++ai)
#pragma unroll
            for (int m = 0; m < 4; ++m) {
                float q = 0.f;
#pragma unroll
                for (int bj = 0; bj < 2; ++bj) {
                    const f32x4 v0 = acc[ai][bj][m][0], v1 = acc[ai][bj][m][1];
                    q += (v0[0] * v0[0] + v0[1] * v0[1]) + (v0[2] * v0[2] + v0[3] * v0[3]) + (v1[0] * v1[0] + v1[1] * v1[1]) + (v1[2] * v1[2] + v1[3] * v1[3]);
                }
                q += __shfl_xor(q, 16); q += __shfl_xor(q, 32);
                if (fq == 0) (void)__hip_atomic_fetch_add(oss + rb + ai * 128 + m * 16, q, __ATOMIC_RELAXED, __HIP_MEMORY_SCOPE_AGENT);
            }
        const int c0 = u.pn * 256 + wc * 32 + 8 * fq;
        f32x4 gp[2][2];
#pragma unroll
        for (int bj = 0; bj < 2; ++bj) { gp[bj][0] = *(const f32x4*)(gpost + c0 + bj * 128); gp[bj][1] = *(const f32x4*)(gpost + c0 + bj * 128 + 4); }
        f32x4 pre[2][2][2];
#pragma unroll
        for (int m = 0; m < 2; ++m)
#pragma unroll
            for (int bj = 0; bj < 2; ++bj) { const size_t off = (size_t)(rb + m * 16) * DM + c0 + bj * 128; pre[m][bj][0] = __builtin_nontemporal_load((const f32x4*)(xp + off)); pre[m][bj][1] = __builtin_nontemporal_load((const f32x4*)(xp + off + 4)); }
        asm volatile("s_waitcnt vmcnt(0)" ::: "memory");
        __builtin_amdgcn_s_barrier();
        if (threadIdx.x == 0) {
            unsigned* cw = cnt + 64 * u.pm;
            (void)__hip_atomic_fetch_add(cw, 1u, __ATOMIC_RELAXED, __HIP_MEMORY_SCOPE_AGENT);
            unsigned sp = 0;
            while (__hip_atomic_load(cw, __ATOMIC_RELAXED, __HIP_MEMORY_SCOPE_AGENT) < 16u) { __builtin_amdgcn_s_sleep(2); if (++sp > (1u << 22)) break; }
        }
        __builtin_amdgcn_s_barrier();
        asm volatile("" ::: "memory");
#pragma unroll
        for (int ai = 0; ai < 2; ++ai)
#pragma unroll
            for (int m = 0; m < 4; ++m) {
                const int row = rb + ai * 128 + m * 16;
                const float tot = __hip_atomic_load(oss + row, __ATOMIC_RELAXED, __HIP_MEMORY_SCOPE_AGENT);
                const float rs = rsqrtf(tot * (1.0f / DM) + EPS);
#pragma unroll
                for (int bj = 0; bj < 2; ++bj) {
                    const size_t off = (size_t)row * DM + c0 + bj * 128;
                    const f32x4 x0 = (ai == 0 && m < 2) ? pre[m & 1][bj][0] : __builtin_nontemporal_load((const f32x4*)(xp + off)), x1 = (ai == 0 && m < 2) ? pre[m & 1][bj][1] : __builtin_nontemporal_load((const f32x4*)(xp + off + 4));
                    __builtin_nontemporal_store(x0 + acc[ai][bj][m][0] * rs * gp[bj][0], (f32x4*)(y + off)); __builtin_nontemporal_store(x1 + acc[ai][bj][m][1] * rs * gp[bj][1], (f32x4*)(y + off + 4));
                }
            }
    }
};
struct EpiSlab {
    bf16_t* F; int ldf, pm0, pn0; size_t slab;
    __device__ __forceinline__ void operator()(const f32x4 (&acc)[2][2][4][2], const pg8::Unit& u, int wr, int wc, int fr, int fq) const {
        asm volatile("" : "+v"(fr), "+v"(fq));
        const int rb = (u.pm - pm0) * 256 + wr * 64 + fr;
        bf16_t* base = F + (size_t)(u.koff >> 10) * slab + (u.pn - pn0) * 256 + wc * 32 + 8 * fq;
#pragma unroll
        for (int ai = 0; ai < 2; ++ai)
#pragma unroll
            for (int m = 0; m < 4; ++m) {
                bf16_t* rp = base + (size_t)(rb + ai * 128 + m * 16) * ldf;
#pragma unroll
                for (int bj = 0; bj < 2; ++bj) { const f32x4 v0 = acc[ai][bj][m][0], v1 = acc[ai][bj][m][1];
                    u32x4 w; w.x = cvt_pk_bf16(v0[0], v0[1]); w.y = cvt_pk_bf16(v0[2], v0[3]); w.z = cvt_pk_bf16(v1[0], v1[1]); w.w = cvt_pk_bf16(v1[2], v1[3]);
                    *(u32x4*)(rp + bj * 128) = w; }
            }
    }
};

template <class EF>
struct EpiMix {
    EF f; EpiSlab q;
    __device__ __forceinline__ void operator()(const f32x4 (&acc)[2][2][4][2], const pg8::Unit& u, int wr, int wc, int fr, int fq) const {
        if (u.kt == 64) f(acc, u, wr, wc, fr, fq); else q(acc, u, wr, wc, fr, fq);
    }
};

__device__ __forceinline__ void transpose_item64(const float* __restrict__ W, int N, bf16_t* __restrict__ WT, int K, int k0, int n0, int drow0, LAS float* scr, int lane) {
    const int lr = lane >> 4, lc = (lane & 15) * 4;
    f32x4 v[16];
#pragma unroll
    for (int i = 0; i < 16; ++i) v[i] = __builtin_nontemporal_load((const f32x4*)(W + (size_t)(k0 + 4 * i + lr) * N + n0 + lc));
#pragma unroll
    for (int i = 0; i < 16; ++i) { LAS float* p = scr + (4 * i + lr) * 65 + lc; p[0] = v[i][0]; p[1] = v[i][1]; p[2] = v[i][2]; p[3] = v[i][3]; }
    LDS_WAIT();
    const int c = lane & 7, nr = lane >> 3;
#pragma unroll
    for (int j = 0; j < 8; ++j) {
        const int n = nr + 8 * j; const LAS float* s = scr + (8 * c) * 65 + n;
        u32x4 o; o.x = cvt_pk_bf16(s[0], s[65]); o.y = cvt_pk_bf16(s[130], s[195]); o.z = cvt_pk_bf16(s[260], s[325]); o.w = cvt_pk_bf16(s[390], s[455]);
        *(u32x4*)(WT + (size_t)(drow0 + n0 + n) * K + k0 + 8 * c) = o;
    }
    LDS_WAIT();
}
__device__ __forceinline__ int win_dest_row(int n) {
    if (n < 1536) return 256 * (n >> 7) + (n & 127);
    if (n < 3072) { n -= 1536; return 256 * (n >> 7) + 128 + (n & 127); }
    if (n < 4608) return 256 * 24 + (n - 3072);
    if (n < 6144) { n -= 4608; return 256 * (12 + (n >> 7)) + (n & 127); }
    if (n < 7680) return 256 * 30 + (n - 6144);
    if (n < 9216) { n -= 7680; return 256 * (12 + (n >> 7)) + 128 + (n & 127); }
    if (n < 10240) return 256 * 36 + (n - 9216);
    return 256 * 40 + (n - 10240);
}
__device__ __forceinline__ void rms_row_bf16(const float* __restrict__ xrow, const float* __restrict__ g, bf16_t* __restrict__ orow, int lane) {
    f32x4 v[16]; float s = 0.f;
#pragma unroll
    for (int j = 0; j < 16; ++j) { v[j] = __builtin_nontemporal_load((const f32x4*)xrow + lane + 64 * j); s += (v[j][0] * v[j][0] + v[j][1] * v[j][1]) + (v[j][2] * v[j][2] + v[j][3] * v[j][3]); }
    s = wave_sum(s);
    const float r = rsqrtf(s * (1.0f / DM) + EPS);
#pragma unroll
    for (int j = 0; j < 16; ++j) {
        const f32x4 gg = ((const f32x4*)g)[lane + 64 * j];
        u32x2 o; o.x = cvt_pk_bf16(v[j][0] * r * gg[0], v[j][1] * r * gg[1]); o.y = cvt_pk_bf16(v[j][2] * r * gg[2], v[j][3] * r * gg[3]);
        ((u32x2*)orow)[lane + 64 * j] = o;
    }
}

#define XB_TMO      128
#define XB_XCNT(j)  (256  + 64 * (j))
#define XB_XSUB(j)  (1280 + 64 * (j))
#define XB_XGEN(j)  (2304 + 64 * (j))
#define XB_TOP      3328
#define XB_TOPGEN   3392
#define XB_SPIN_CAP (1u << 20)
__device__ __forceinline__ unsigned xb_ld(unsigned* p)              { return __hip_atomic_load(p, __ATOMIC_RELAXED, __HIP_MEMORY_SCOPE_AGENT); }
__device__ __forceinline__ unsigned xb_add(unsigned* p, unsigned v) { return __hip_atomic_fetch_add(p, v, __ATOMIC_RELAXED, __HIP_MEMORY_SCOPE_AGENT); }
__device__ __forceinline__ unsigned xb_xcc_id() { return (unsigned)__builtin_amdgcn_s_getreg((3 << 11) | 20) & 0xFu; }
#define XB_SPIN(cond, bar) do { unsigned _sp = 0; while (cond) { __builtin_amdgcn_s_sleep(1); \
    if ((++_sp & 255u) == 0u) { if (xb_ld(&(bar)[XB_TMO])) break; if (_sp > XB_SPIN_CAP) { atomicAdd(&(bar)[XB_TMO], 1u); break; } } } } while (0)
struct XcdBarrier { unsigned* bar; unsigned x; volatile LAS unsigned* st; };
__device__ __forceinline__ XcdBarrier xcd_barrier_post(unsigned* bar, volatile LAS unsigned* st) {
    XcdBarrier b; b.bar = bar; b.x = xb_xcc_id(); b.st = st;
    if (threadIdx.x == 0) (void)xb_add(&bar[XB_XCNT(b.x)], 1u);
    return b;
}
__device__ __forceinline__ void xcd_barrier_complete(unsigned* bar, unsigned x, unsigned& nloc, unsigned& nx) {
    const unsigned G = gridDim.x * gridDim.y * gridDim.z;
    unsigned sum, cnt, mine, sp = 0u;
    for (;;) {
        sum = 0u; cnt = 0u; mine = 0u;
#pragma unroll
        for (unsigned j = 0; j < 16; ++j) { const unsigned c = xb_ld(&bar[XB_XCNT(j)]); sum += c; cnt += (c > 0u) ? 1u : 0u; mine = (j == x) ? c : mine; }
        if (sum == G) break;
        __builtin_amdgcn_s_sleep(1);
        if ((++sp & 255u) == 0u) { if (xb_ld(&bar[XB_TMO])) break; if (sp > XB_SPIN_CAP) { atomicAdd(&bar[XB_TMO], 1u); break; } }
    }
    nloc = mine > 0u ? mine : 1u; nx = cnt > 0u ? cnt : 1u;
}
__device__ __forceinline__ void xcd_barrier(const XcdBarrier& b) {
    asm volatile("s_waitcnt vmcnt(0)" ::: "memory");
    __syncthreads();
    if (threadIdx.x == 0) {
        unsigned* bar = b.bar;
        __builtin_amdgcn_s_waitcnt(0);
        unsigned nloc = b.st[0], nx = b.st[1];
        if (nloc == 0u) { xcd_barrier_complete(bar, b.x, nloc, nx); b.st[0] = nloc; b.st[1] = nx; }
        const unsigned old = xb_add(&bar[XB_XSUB(b.x)], 1u);
        const unsigned gen = old / nloc;
        if (old + 1u == (gen + 1u) * nloc) {
            __builtin_amdgcn_fence(__ATOMIC_RELEASE, "agent");
            asm volatile("s_waitcnt vmcnt(0)" ::: "memory");
            const unsigned og = xb_add(&bar[XB_TOP], 1u);
            const unsigned tg = og / nx;
            if (og + 1u == (tg + 1u) * nx) xb_add(&bar[XB_TOPGEN], 1u);
            else XB_SPIN(xb_ld(&bar[XB_TOPGEN]) == tg, bar);
            __builtin_amdgcn_fence(__ATOMIC_ACQUIRE, "agent");
            xb_add(&bar[XB_XGEN(b.x)], 1u);
            asm volatile("s_waitcnt vmcnt(0)" ::: "memory");
        } else {
            XB_SPIN(xb_ld(&bar[XB_XGEN(b.x)]) == gen, bar);
            __builtin_amdgcn_fence(__ATOMIC_ACQUIRE, "agent");
            asm volatile("s_waitcnt vmcnt(0)" ::: "memory");
        }
    }
    __syncthreads();
}

struct Args {
    const float* in[22]; float* out; unsigned char* ws;
};

constexpr int KVB = 512;
__device__ __forceinline__ int kv_off(int row, int chunk) { return row * KVB + ((chunk ^ ((row & 15) ^ (((row >> 4) & 1) << 2))) << 4); }
constexpr int KVH = 128 * KVB;
__device__ __forceinline__ void attn_dma(const bf16_t* base, int pitch, LAS unsigned char* buf, int wave, int lane) {
#pragma unroll
    for (int i = 0; i < 8; ++i) {
        const int r = 2 * (8 * wave + i) + (lane >> 5), cs = lane & 31, cg = cs ^ ((r & 15) ^ (((r >> 4) & 1) << 2));
        __builtin_amdgcn_global_load_lds((const unsigned*)(base + (size_t)r * pitch + cg * 8), (LAS unsigned*)(buf + (8 * wave + i) * 1024), 16, 0, 0);
    }
}
#define ATTN_LAND() do { asm volatile("s_waitcnt vmcnt(0)" ::: "memory"); __syncthreads(); } while (0)
__device__ __forceinline__ float attn_epi8(const f32x4 (&o)[8], float inv, const bf16_t* P, bf16_t* MIX, int qrow, int c0, int g) {
    float ss = 0.f;
#pragma unroll
    for (int p = 0; p < 4; ++p) {
        const int c = c0 + 32 * p + 8 * g;
        const u32x4 sg = *(const u32x4*)(P + (size_t)qrow * PW + P_SGX + c);
        f32x4 y0 = o[2 * p] * inv, y1 = o[2 * p + 1] * inv;
        y0[0] *= bflo(sg.x); y0[1] *= bfhi(sg.x); y0[2] *= bflo(sg.y); y0[3] *= bfhi(sg.y);
        y1[0] *= bflo(sg.z); y1[1] *= bfhi(sg.z); y1[2] *= bflo(sg.w); y1[3] *= bfhi(sg.w);
        ss += ((y0[0] * y0[0] + y0[1] * y0[1]) + (y0[2] * y0[2] + y0[3] * y0[3])) + ((y1[0] * y1[0] + y1[1] * y1[1]) + (y1[2] * y1[2] + y1[3] * y1[3]));
        u32x4 w; w.x = cvt_pk_bf16(y0[0], y0[1]); w.y = cvt_pk_bf16(y0[2], y0[3]); w.z = cvt_pk_bf16(y1[0], y1[1]); w.w = cvt_pk_bf16(y1[2], y1[3]);
        *(u32x4*)(MIX + (size_t)qrow * DM + 3072 + c) = w;
    }
    return ss;
}
__device__ __forceinline__ void attn_unit(int a, const bf16_t* P, const bf16_t* QF, const bf16_t* KB, const bf16_t* VTM, const float* g_branch,
                                          bf16_t* MIX, LAS unsigned char* kv, int tid, int wave, int lane) {
    int row0, bm, nq;
    if (a < 64) { row0 = a * 128; bm = a >> 5; nq = 8; } else { row0 = MP + (a - 64) * 64; bm = 2 + (a - 64); nq = 4; }
    const bool active = wave < nq;
    const int l150 = lane & 15, g0 = lane >> 4, l15 = l150, g = g0;
    const int qrow = row0 + 16 * (active ? wave : 0) + l15;
    const bf16_t* kg = KB + (size_t)(bm * 256) * 1024;
    const bf16_t* vg = VTM + (size_t)(bm * 4) * 256 * 256;
    const int krow0 = 8 * (l15 >> 2) + (l15 & 3);
    LAS unsigned char* bufA = kv; LAS unsigned char* bufB = kv + KVH;
    attn_dma(kg, 1024, bufA, wave, opq(lane));
    ATTN_LAND();
    float ss = 0.f;
#pragma unroll 1
    for (int h = 0; h < 4; ++h) {
        attn_dma(kg + h * 256 + (size_t)128 * 1024, 1024, bufB, wave, opq(lane));
        bf16x8 qf[8];
        if (active) {
            if (row0 < 4096) {
#pragma unroll
                for (int ks = 0; ks < 8; ++ks) {
                    const bf16_t* qp = QF + (size_t)qrow * CX + h * 256 + 32 * ks + 8 * g;
                    const u32x4 p0 = *(const u32x4*)qp, p1 = *(const u32x4*)(qp + SLAB), p2 = *(const u32x4*)(qp + 2 * SLAB), p3 = *(const u32x4*)(qp + 3 * SLAB);
                    u32x4 w;
#pragma unroll
                    for (int e = 0; e < 4; ++e) w[e] = cvt_pk_bf16(((bflo(p0[e]) + bflo(p1[e])) + (bflo(p2[e]) + bflo(p3[e]))) * QSCALE, ((bfhi(p0[e]) + bfhi(p1[e])) + (bfhi(p2[e]) + bfhi(p3[e]))) * QSCALE);
                    qf[ks] = __builtin_bit_cast(bf16x8, w);
                }
            } else {
#pragma unroll
                for (int ks = 0; ks < 8; ++ks) qf[ks] = *(const bf16x8*)(P + (size_t)qrow * PW + P_Q + h * 256 + 32 * ks + 8 * g);
            }
        }
        f32x4 s[16];
        if (active) {
            const int krow = opq(krow0), g = opq(g0);
#pragma unroll
            for (int kt = 0; kt < 16; ++kt) s[kt] = (f32x4){0.f, 0.f, 0.f, 0.f};
#pragma unroll
            for (int ks = 0; ks < 8; ++ks)
                {
#pragma unroll
                  for (int kt = 0; kt < 8; ++kt) s[kt] = __builtin_amdgcn_mfma_f32_16x16x32_bf16(*(const LAS bf16x8*)(bufA + kv_off(32 * (kt >> 1) + 4 * (kt & 1) + krow, 4 * ks + g)), qf[ks], s[kt], 0, 0, 0);
                  __builtin_amdgcn_sched_barrier(0); }
        }
        ATTN_LAND();
        attn_dma(vg + (size_t)h * 256 * 256, 256, bufA, wave, opq(lane));
        bf16x8 pf[8]; float inv = 0.f;
        if (active) {
            const int krow = opq(krow0), g = opq(g0);
#pragma unroll
            for (int ks = 0; ks < 8; ++ks)
                {
#pragma unroll
                  for (int kt = 8; kt < 16; ++kt) s[kt] = __builtin_amdgcn_mfma_f32_16x16x32_bf16(*(const LAS bf16x8*)(bufB + kv_off(32 * ((kt - 8) >> 1) + 4 * (kt & 1) + krow, 4 * ks + g)), qf[ks], s[kt], 0, 0, 0);
                  __builtin_amdgcn_sched_barrier(0); }
            float mx = s[0][0];
#pragma unroll
            for (int kt = 0; kt < 16; ++kt)
#pragma unroll
                for (int j = 0; j < 4; ++j) mx = fmaxf(mx, s[kt][j]);
            mx = fmaxf(mx, __shfl_xor(mx, 16)); mx = fmaxf(mx, __shfl_xor(mx, 32));
            float l = 0.f;
#pragma unroll
            for (int kt = 0; kt < 16; ++kt)
#pragma unroll
                for (int j = 0; j < 4; ++j) { const float p = __builtin_amdgcn_exp2f(s[kt][j] - mx); s[kt][j] = p; l += p; }
            l += __shfl_xor(l, 16); l += __shfl_xor(l, 32);
            inv = 1.0f / l;
#pragma unroll
            for (int si = 0; si < 8; ++si) {
                u32x4 w; w.x = cvt_pk_bf16(s[2 * si][0], s[2 * si][1]); w.y = cvt_pk_bf16(s[2 * si][2], s[2 * si][3]);
                w.z = cvt_pk_bf16(s[2 * si + 1][0], s[2 * si + 1][1]); w.w = cvt_pk_bf16(s[2 * si + 1][2], s[2 * si + 1][3]);
                pf[si] = __builtin_bit_cast(bf16x8, w);
            }
        }
        ATTN_LAND();
        attn_dma(vg + (size_t)h * 256 * 256 + (size_t)128 * 256, 256, bufB, wave, opq(lane));
        if (active) {
            const int krow = opq(krow0), g = opq(g0);
            f32x4 o[8];
#pragma unroll
            for (int dt = 0; dt < 8; ++dt) o[dt] = (f32x4){0.f, 0.f, 0.f, 0.f};
#pragma unroll
            for (int si = 0; si < 8; ++si)
                {
#pragma unroll
                  for (int dt = 0; dt < 8; ++dt) o[dt] = __builtin_amdgcn_mfma_f32_16x16x32_bf16(*(const LAS bf16x8*)(bufA + kv_off(32 * (dt >> 1) + 4 * (dt & 1) + krow, 4 * si + g)), pf[si], o[dt], 0, 0, 0);
                  __builtin_amdgcn_sched_barrier(0); }
            ss += attn_epi8(o, inv, P, MIX, qrow, h * 256, g);
        }
        ATTN_LAND();
        if (h < 3) attn_dma(kg + (h + 1) * 256, 1024, bufA, wave, opq(lane));
        if (active) {
            const int krow = opq(krow0), g = opq(g0);
            f32x4 o[8];
#pragma unroll
            for (int dt = 0; dt < 8; ++dt) o[dt] = (f32x4){0.f, 0.f, 0.f, 0.f};
#pragma unroll
            for (int si = 0; si < 8; ++si)
                {
#pragma unroll
                  for (int dt = 0; dt < 8; ++dt) o[dt] = __builtin_amdgcn_mfma_f32_16x16x32_bf16(*(const LAS bf16x8*)(bufB + kv_off(32 * (dt >> 1) + 4 * (dt & 1) + krow, 4 * si + g)), pf[si], o[dt], 0, 0, 0);
                  __builtin_amdgcn_sched_barrier(0); }
            ss += attn_epi8(o, inv, P, MIX, qrow, h * 256 + 128, g);
        }
        ATTN_LAND();
    }
    if (active) {
        ss += __shfl_xor(ss, 16); ss += __shfl_xor(ss, 32);
        const float rs = rsqrtf(ss * (1.0f / CX) + EPS);
        asm volatile("s_waitcnt vmcnt(0)" ::: "memory");
#pragma unroll 1
        for (int b = 0; b < 4; ++b) {
            bf16_t* mp = MIX + (size_t)qrow * DM + 3072 + 256 * b + 8 * g;
            u32x4 yv[8];
#pragma unroll
            for (int i = 0; i < 8; ++i) yv[i] = *(const u32x4*)(mp + 32 * i);
#pragma unroll
            for (int i = 0; i < 8; ++i) {
                const float* gp = g_branch + 3072 + 256 * b + 32 * i + 8 * g;
                const f32x4 g0v = *(const f32x4*)gp, g1v = *(const f32x4*)(gp + 4);
                u32x4 w; w.x = cvt_pk_bf16(bflo(yv[i].x) * rs * g0v[0], bfhi(yv[i].x) * rs * g0v[1]); w.y = cvt_pk_bf16(bflo(yv[i].y) * rs * g0v[2], bfhi(yv[i].y) * rs * g0v[3]);
                w.z = cvt_pk_bf16(bflo(yv[i].z) * rs * g1v[0], bfhi(yv[i].z) * rs * g1v[1]); w.w = cvt_pk_bf16(bflo(yv[i].w) * rs * g1v[2], bfhi(yv[i].w) * rs * g1v[3]);
                *(u32x4*)(mp + 32 * i) = w;
            }
        }
    }
    __syncthreads();
}

__device__ __forceinline__ void gmlp_unit(int u, const bf16_t* P, const bf16_t* VT, const float* vstat, const float* Ws, const float* bsp,
                                          const float* lvg, const float* lvb, const float* g_branch, float* GV, bf16_t* MIX,
                                          LAS float* sm, int tid, int wave, int lane) {
    int row0, ib; bool sample;
    if (u < 512) { row0 = (u >> 3) * 128; ib = u & 7; sample = false; } else { const int v = u - 512; row0 = MP + (v >> 2) * 64; ib = v & 3; sample = true; }
    const int i0 = 16 * ib, nks = (i0 + 47) >> 5, nj = i0 + 16;
    LAS float* sm_mean = sm; LAS float* sm_rstd = sm + 128; LAS float* sm_part = sm + 256;
    if (tid < 128) {
        float mean = 0.f, rstd = 0.f;
        if (tid < nj) { const float s1 = vstat[2 * (row0 + tid)], s2 = vstat[2 * (row0 + tid) + 1]; mean = s1 * (1.0f / CC); const float var = fmaxf(s2 * (1.0f / CC) - mean * mean, 0.f); rstd = rsqrtf(var + EPS); }
        sm_mean[tid] = mean; sm_rstd[tid] = rstd;
    }
    __syncthreads();
    if (sample && GV) {
        float* gv = GV + (size_t)(row0 - MP + i0) * CC;
        for (int e = tid; e < 16 * 384; e += NTHREADS) {
            const int r = e / 384, c4 = (e - r * 384) * 4;
            f32x4 v = *(f32x4*)(gv + (size_t)r * CC + c4); const f32x4 gg = *(const f32x4*)(lvg + c4), bb = *(const f32x4*)(lvb + c4);
            const float mean = sm_mean[i0 + r], rstd = sm_rstd[i0 + r];
            v = (v - mean) * rstd * gg + bb;
            *(f32x4*)(gv + (size_t)r * CC + c4) = v;
        }
    }
    const int h = wave >> 1, cw0 = 192 * wave, l15 = lane & 15, g = lane >> 4;
    const int i = i0 + l15;
    bf16x8 wf[4]; float c1 = 0.f, c2 = 0.f;
    {
        const float* wrow = Ws + ((size_t)h * 128 + i) * 128;
#pragma unroll
        for (int ks = 0; ks < 4; ++ks) {
            u32x4 w = (u32x4){0u, 0u, 0u, 0u};
            if (ks < nks) {
                const int j0 = 32 * ks + 8 * g; const f32x4 w0 = *(const f32x4*)(wrow + j0), w1 = *(const f32x4*)(wrow + j0 + 4);
                const f32x4 r0 = *(const LAS f32x4*)(sm_rstd + j0), r1 = *(const LAS f32x4*)(sm_rstd + j0 + 4), m0 = *(const LAS f32x4*)(sm_mean + j0), m1 = *(const LAS f32x4*)(sm_mean + j0 + 4);
                float wv[8] = {w0[0], w0[1], w0[2], w0[3], w1[0], w1[1], w1[2], w1[3]};
                const float rv[8] = {r0[0], r0[1], r0[2], r0[3], r1[0], r1[1], r1[2], r1[3]}, mv[8] = {m0[0], m0[1], m0[2], m0[3], m1[0], m1[1], m1[2], m1[3]};
#pragma unroll
                for (int e = 0; e < 8; ++e) { const int j = j0 + e; const float wm = (j <= i) ? wv[e] : 0.f; const float wp = wm * rv[e]; c1 += wp * mv[e]; c2 += wm; wv[e] = wp; }
                w.x = cvt_pk_bf16(wv[0], wv[1]); w.y = cvt_pk_bf16(wv[2], wv[3]); w.z = cvt_pk_bf16(wv[4], wv[5]); w.w = cvt_pk_bf16(wv[6], wv[7]);
            }
            wf[ks] = __builtin_bit_cast(bf16x8, w);
        }
        c1 += __shfl_xor(c1, 16); c1 += __shfl_xor(c1, 32); c2 += __shfl_xor(c2, 16); c2 += __shfl_xor(c2, 32);
    }
    f32x4 z[12];
#pragma unroll
    for (int nt = 0; nt < 12; ++nt) z[nt] = (f32x4){0.f, 0.f, 0.f, 0.f};
#pragma unroll
    for (int nt = 0; nt < 12; ++nt) {
        const bf16_t* vp = VT + (size_t)(cw0 + 16 * nt + l15) * MT + row0 + 8 * g;
#pragma unroll
        for (int ks = 0; ks < 4; ++ks) if (ks < nks) {
            const bf16x8 vf = *(const bf16x8*)(vp + 32 * ks);
            z[nt] = __builtin_amdgcn_mfma_f32_16x16x32_bf16(vf, wf[ks], z[nt], 0, 0, 0);
        }
    }
    const float bs = bsp[h * 128 + i];
    const int row = row0 + i;
    float ss = 0.f;
#pragma unroll
    for (int nt = 0; nt < 12; ++nt) {
        const int c = cw0 + 16 * nt + 4 * g; const f32x4 gv = *(const f32x4*)(lvg + c), bv = *(const f32x4*)(lvb + c);
        const u32x2 ug = *(const u32x2*)(P + (size_t)row * PW + P_UG + c);
        const float uu[4] = {bflo(ug.x), bfhi(ug.x), bflo(ug.y), bfhi(ug.y)};
        f32x4 y;
#pragma unroll
        for (int j = 0; j < 4; ++j) { const float zz = gv[j] * (z[nt][j] - c1) + bv[j] * c2 + bs; y[j] = uu[j] * zz; }
        z[nt] = y; ss += (y[0] * y[0] + y[1] * y[1]) + (y[2] * y[2] + y[3] * y[3]);
    }
    ss += __shfl_xor(ss, 16); ss += __shfl_xor(ss, 32);
    if (g == 0) sm_part[wave * 16 + l15] = ss;
    __syncthreads();
    {
        float tot = 0.f;
#pragma unroll
        for (int w = 0; w < 8; ++w) tot += sm_part[w * 16 + l15];
        const float rs = rsqrtf(tot * (1.0f / CC) + EPS);
#pragma unroll
        for (int nt = 0; nt < 12; ++nt) {
            const int c = cw0 + 16 * nt + 4 * g; const f32x4 gb = *(const f32x4*)(g_branch + CC + c);
            const f32x4 y = z[nt] * rs * gb;
            u32x2 w; w.x = cvt_pk_bf16(y[0], y[1]); w.y = cvt_pk_bf16(y[2], y[3]);
            *(u32x2*)(MIX + (size_t)row * DM + CC + c) = w;
        }
    }
    __syncthreads();
}

__device__ __forceinline__ void conv_unit(int a, const bf16_t* P, const bf16_t* GLU, const float* cw, const float* cb,
                                          const float* lg, const float* lb, const float* g_branch, bf16_t* MIX,
                                          LAS float* cbuf, int tid, int wave, int lane) {
    const int row0 = 16 * a;
    const bf16_t* gbase = GLU + (size_t)(glu_row(row0) - 30) * CC;
    const __amdgpu_buffer_rsrc_t rx = __builtin_amdgcn_make_buffer_rsrc((void*)gbase, 0, 46 * CC * 2, 0x00020000);
    const __amdgpu_buffer_rsrc_t rw = __builtin_amdgcn_make_buffer_rsrc((void*)cw, 0, 31 * CC * 4, 0x00020000);
#pragma unroll 1
    for (int it = 0; it < 2; ++it) {
        const int cp = tid + 512 * it;
        if (cp < CC / 2) {
            float w[31][2];
#pragma unroll
            for (int j = 0; j < 31; ++j) { w[j][0] = __builtin_bit_cast(float, __builtin_amdgcn_raw_buffer_load_b32(rw, cp * 8, j * CC * 4, 0)); w[j][1] = __builtin_bit_cast(float, __builtin_amdgcn_raw_buffer_load_b32(rw, cp * 8 + 4, j * CC * 4, 0)); }
            float acc[16][2];
            const float b0 = cb[2 * cp], b1 = cb[2 * cp + 1];
#pragma unroll
            for (int tt = 0; tt < 16; ++tt) { acc[tt][0] = b0; acc[tt][1] = b1; }
#pragma unroll
            for (int r = 0; r < 46; ++r) {
                const unsigned xv = (unsigned)__builtin_amdgcn_raw_buffer_load_b32(rx, cp * 4, r * CC * 2, 0);
                const float x0 = bflo(xv), x1 = bfhi(xv);
#pragma unroll
                for (int tt = 0; tt < 16; ++tt) if (r - tt >= 0 && r - tt <= 30) { acc[tt][0] += w[r - tt][0] * x0; acc[tt][1] += w[r - tt][1] * x1; }
            }
#pragma unroll
            for (int tt = 0; tt < 16; ++tt) { LAS float* d = cbuf + tt * CC + 2 * cp; d[0] = acc[tt][0]; d[1] = acc[tt][1]; }
        }
    }
    __syncthreads();
#pragma unroll
    for (int ti = 0; ti < 2; ++ti) {
        const int tt = 2 * wave + ti, row = row0 + tt;
        f32x4 v[6]; float s1 = 0.f, s2 = 0.f;
#pragma unroll
        for (int i = 0; i < 6; ++i) { v[i] = *(const LAS f32x4*)(cbuf + tt * CC + 4 * lane + 256 * i);
            s1 += (v[i][0] + v[i][1]) + (v[i][2] + v[i][3]); s2 += (v[i][0] * v[i][0] + v[i][1] * v[i][1]) + (v[i][2] * v[i][2] + v[i][3] * v[i][3]); }
        s1 = wave_sum(s1); s2 = wave_sum(s2);
        const float mean = s1 * (1.0f / CC), var = fmaxf(s2 * (1.0f / CC) - mean * mean, 0.f), rstd = rsqrtf(var + EPS);
        float q = 0.f;
#pragma unroll
        for (int i = 0; i < 6; ++i) {
            const int c = 4 * lane + 256 * i;
            const f32x4 gg = *(const f32x4*)(lg + c), bb = *(const f32x4*)(lb + c);
            const u32x2 sg = *(const u32x2*)(P + (size_t)row * PW + P_SGC + c);
            const float sv[4] = {bflo(sg.x), bfhi(sg.x), bflo(sg.y), bfhi(sg.y)};
#pragma unroll
            for (int j = 0; j < 4; ++j) { float y = (v[i][j] - mean) * rstd * gg[j] + bb[j]; y = y * sigmoidf_(y) * sv[j]; v[i][j] = y; q += y * y; }
        }
        q = wave_sum(q);
        const float rs = rsqrtf(q * (1.0f / CC) + EPS);
#pragma unroll
        for (int i = 0; i < 6; ++i) {
            const int c = 4 * lane + 256 * i;
            const f32x4 gb = *(const f32x4*)(g_branch + c);
            const f32x4 y = v[i] * rs * gb;
            u32x2 o; o.x = cvt_pk_bf16(y[0], y[1]); o.y = cvt_pk_bf16(y[2], y[3]);
            *(u32x2*)(MIX + (size_t)row * DM + c) = o;
        }
    }
    __syncthreads();
}

__global__ void __launch_bounds__(NTHREADS, 2) mega_fwd(Args args) {
    extern __shared__ __attribute__((aligned(16))) unsigned char lds_raw[];
    LAS unsigned char* lds = (LAS unsigned char*)lds_raw;
    cg::grid_group grid = cg::this_grid();
    const int tid = threadIdx.x, lane = tid & 63, wave = __builtin_amdgcn_readfirstlane(tid >> 6);
    const int G = gridDim.x, bx = blockIdx.x;
    unsigned char* ws = args.ws;
    float* out = args.out;
    const float* x_prompt = args.in[0]; const float* x_sample = args.in[1]; const float* mem_prompt = args.in[2];
    const float* cache_k = args.in[3]; const float* cache_v = args.in[4]; const float* cache_conv = args.in[5];
    const float* g_pre = args.in[6]; const float* w_in = args.in[7]; const float* conv_w = args.in[8]; const float* conv_b = args.in[9];
    const float* ln_conv_g = args.in[10]; const float* ln_conv_b = args.in[11]; const float* ln_v_g = args.in[12]; const float* ln_v_b = args.in[13];
    const float* w_spatial = args.in[14]; const float* b_spatial = args.in[15]; const float* g_mem = args.in[16]; const float* w_mk = args.in[17]; const float* w_mv = args.in[18];
    const float* g_branch = args.in[19]; const float* w_out = args.in[20]; const float* g_post = args.in[21];
    unsigned* ctl = (unsigned*)(ws + WS_CTL);
    volatile LAS unsigned* bst = (volatile LAS unsigned*)(lds + LDS_BYTES - 16);
    if (tid < 4) bst[tid] = 0u;
    __syncthreads();
    const XcdBarrier xbar = xcd_barrier_post((unsigned*)(ws + CTL_BAR), bst);
    float* vstat = (float*)(ws + CTL_VSTAT); float* oss = (float*)(ws + CTL_OSS);
    bf16_t* WT = (bf16_t*)(ws + WS_WT); bf16_t* WO = (bf16_t*)(ws + WS_WO); bf16_t* H = (bf16_t*)(ws + WS_H); bf16_t* PB = (bf16_t*)(ws + WS_P);
    bf16_t* VT = (bf16_t*)(ws + WS_VT); bf16_t* KB = (bf16_t*)(ws + WS_KB); bf16_t* VTM = (bf16_t*)(ws + WS_VTM); bf16_t* MIX = (bf16_t*)(ws + WS_MIX); bf16_t* OB = (bf16_t*)(ws + WS_OUT); bf16_t* GLU = (bf16_t*)(ws + WS_GLU); bf16_t* QF = (bf16_t*)(ws + WS_QF); bf16_t* OF = (bf16_t*)(ws + WS_OF);

#ifndef REP_P0
#define REP_P0 1
#endif
#ifndef REP_P2
#define REP_P2 1
#endif
#ifndef REP_P4
#define REP_P4 1
#endif
    for (int rep0 = 0; rep0 < REP_P0; ++rep0) {
        const int gw = bx * 8 + wave, NGW = G * 8;
        LAS float* scr = (LAS float*)(lds + wave * 16640);
        constexpr int I_IN = 64 * 176, I_MK = 64 * 16, I_CV = 16 * 64, NITEMS = I_IN + 2 * I_MK + I_CV;
        for (int it = gw; it < NITEMS; it += NGW) {
            int r = it;
            if (r < I_IN) { const int kb = r / 176, nb = r - kb * 176; transpose_item64(w_in, NIN, WT, DM, 64 * kb, 64 * nb, win_dest_row(64 * nb) - 64 * nb, scr, lane); continue; } r -= I_IN;
            if (r < I_MK) { const int kb = r >> 4, nb = r & 15; transpose_item64(w_mk, CX, WT, DM, 64 * kb, 64 * nb, NIN, scr, lane); continue; } r -= I_MK;
            if (r < I_MK) { const int kb = r >> 4, nb = r & 15; transpose_item64(w_mv, CX, WT, DM, 64 * kb, 64 * nb, NIN + CX, scr, lane); continue; } r -= I_MK;
            { const int b = r >> 6, q = r & 63, kb = q >> 4, nb = q & 15; transpose_item64(cache_v + (size_t)b * 256 * 1024, 1024, VTM + (size_t)(2 + b) * 1024 * 256, 256, 64 * kb, 64 * nb, 0, scr, lane); }
        }
        for (int m = gw; m < MT + MEMR; m += NGW) {
            const float* src; const float* gg;
            if (m < MP) { src = x_prompt + (size_t)m * DM; gg = g_pre; } else if (m < MT) { src = x_sample + (size_t)(m - MP) * DM; gg = g_pre; } else { src = mem_prompt + (size_t)(m - MT) * DM; gg = g_mem; }
            rms_row_bf16(src, gg, H + (size_t)m * DM, lane);
        }
        for (int i = gw * 64 + lane; i < 16 * 256 * 1024 / 4; i += NGW * 64) {
            const f32x4 v = __builtin_nontemporal_load((const f32x4*)cache_k + i);
            u32x2 o; o.x = cvt_pk_bf16(v[0], v[1]); o.y = cvt_pk_bf16(v[2], v[3]);
            ((u32x2*)(KB + (size_t)2 * 256 * 1024))[i] = o;
        }
        for (int i = gw * 64 + lane; i < 18 * 30 * CC / 4; i += NGW * 64) {
            const int hr = i / (CC / 4), c4 = i - hr * (CC / 4), b = hr / 30, r = hr - b * 30;
            u32x2 o = (u32x2){0u, 0u};
            if (b >= 2) { const f32x4 v = ((const f32x4*)cache_conv)[i - 2 * 30 * CC / 4]; o.x = cvt_pk_bf16(v[0], v[1]); o.y = cvt_pk_bf16(v[2], v[3]); }
            const int grow = (b < 2 ? b * 4126 : 8252 + (b - 2) * 94) + r;
            ((u32x2*)(GLU + (size_t)grow * CC))[c4] = o;
        }
    }
    if (gridDim.y == 0x7fffu) grid.sync();
    xcd_barrier(xbar);

    {
#ifndef NO_G1
        { pg8::Gemm g{H, WT, DM}; Sched1 S{bx}; EpiMix<Epi1> E{Epi1{PB, GLU, VT, vstat, out, KB, VTM}, EpiSlab{QF, CX, 0, 36, SLAB}};
          pg8::gemm_phase<EpiMix<Epi1>, Sched1>(lds, g, S, E); }
#endif
    }
    xcd_barrier(xbar);

    for (int rep2 = 0; rep2 < REP_P2; ++rep2) {
        LAS float* cbuf = (LAS float*)lds;
        LAS float* sm = (LAS float*)(lds + 135168);
        LAS int* sm_next = (LAS int*)(lds + 135168 + 4096);
        constexpr int NA = 80, NC = 576, NB = 576, NW = 512, NU = NA + NC + NB + NW;
        for (;;) {
            if (tid == 0) *sm_next = (int)atomicAdd(ctl + 64 * rep2, 1u);
            __syncthreads();
            const int u = __builtin_amdgcn_readfirstlane(*sm_next);
            __syncthreads();
            if (u >= NU) break;
            int tidv = tid, wv = wave;
            asm volatile("" : "+v"(tidv), "+s"(wv));
            tidv &= 511; wv &= 7;
            const int lanev = tidv & 63;
#ifndef P2_MASK
#define P2_MASK 7
#endif
            const int pmask = rep2 == 0 ? 7 : P2_MASK;
            if (u >= NA + NC + NB) {
                const int it = 8 * (u - NA - NC - NB) + wv;
                transpose_item64(w_out, DM, WO, DM, 64 * (it >> 6), 64 * (it & 63), 0, (LAS float*)(lds + wv * 16640), lanev);
                __syncthreads();
            } else if (u < NA) {
                if (pmask & 1) {
#ifndef NO_ATTN
                attn_unit(u, PB, QF, KB, VTM, g_branch, MIX, lds, tidv, wv, lanev);
#endif
                }
            } else if (u < NA + NC) {
                if (pmask & 2) {
#ifndef NO_CONV
                conv_unit(u - NA, PB, GLU, conv_w, conv_b, ln_conv_g, ln_conv_b, g_branch, MIX, cbuf, tidv, wv, lanev);
#endif
                }
            } else {
                if (pmask & 4) {
#ifndef NO_GMLP
                gmlp_unit(u - NA - NC, PB, VT, vstat, w_spatial, b_spatial, ln_v_g, ln_v_b, g_branch, rep2 == 0 ? out + O_GV : nullptr, MIX, sm, tidv, wv, lanev);
#endif
                }
            }
        }
    }
    xcd_barrier(xbar);

    {
#ifndef NO_G2
        { pg8::Gemm g{MIX, WO, DM}; Sched2 S{bx}; EpiMix<Epi2F> E{Epi2F{x_prompt, g_post, out + O_Y, oss, (unsigned*)(ws + CTL_PCNT)}, EpiSlab{OF, DM, 32, 0, SLAB}};
          pg8::gemm_phase<EpiMix<Epi2F>, Sched2>(lds, g, S, E); }
#endif
    }
    xcd_barrier(xbar);

    for (int rep4 = 0; rep4 < REP_P4; ++rep4) {
        const int lane = opq(tid) & 63;
        const int gw = bx * 8 + wave, NGW = G * 8;
        for (int m = MP + gw; m < MT; m += NGW) {
            float* yr = out + O_Y + (size_t)m * DM;
            if (m < MP) {
                const float* xr = x_prompt + (size_t)m * DM; const bf16_t* orow = OB + (size_t)m * DM;
                u32x4 ov[8]; f32x4 xv[16]; float q = 0.f;
#pragma unroll
                for (int j = 0; j < 8; ++j) ov[j] = *(const u32x4*)(orow + (lane + 64 * j) * 8);
#pragma unroll
                for (int j = 0; j < 8; ++j) { xv[2 * j] = *(const f32x4*)(xr + (lane + 64 * j) * 8); xv[2 * j + 1] = *(const f32x4*)(xr + (lane + 64 * j) * 8 + 4); }
#pragma unroll
                for (int j = 0; j < 8; ++j) {
                    const float a0 = bflo(ov[j].x), a1 = bfhi(ov[j].x), a2 = bflo(ov[j].y), a3 = bfhi(ov[j].y), a4 = bflo(ov[j].z), a5 = bfhi(ov[j].z), a6 = bflo(ov[j].w), a7 = bfhi(ov[j].w);
                    q += (a0 * a0 + a1 * a1) + (a2 * a2 + a3 * a3) + (a4 * a4 + a5 * a5) + (a6 * a6 + a7 * a7); }
                q = wave_sum(q);
                const float rs = rsqrtf(q * (1.0f / DM) + EPS);
#pragma unroll
                for (int j = 0; j < 8; ++j) {
                    const int c = (lane + 64 * j) * 8;
                    const f32x4 x0 = xv[2 * j], x1 = xv[2 * j + 1], g0 = *(const f32x4*)(g_post + c), g1 = *(const f32x4*)(g_post + c + 4);
                    f32x4 y0, y1;
                    y0[0] = x0[0] + bflo(ov[j].x) * rs * g0[0]; y0[1] = x0[1] + bfhi(ov[j].x) * rs * g0[1]; y0[2] = x0[2] + bflo(ov[j].y) * rs * g0[2]; y0[3] = x0[3] + bfhi(ov[j].y) * rs * g0[3];
                    y1[0] = x1[0] + bflo(ov[j].z) * rs * g1[0]; y1[1] = x1[1] + bfhi(ov[j].z) * rs * g1[1]; y1[2] = x1[2] + bflo(ov[j].w) * rs * g1[2]; y1[3] = x1[3] + bfhi(ov[j].w) * rs * g1[3];
                    *(f32x4*)(yr + c) = y0; *(f32x4*)(yr + c + 4) = y1;
                }
            } else {
                const float* xr = x_sample + (size_t)(m - MP) * DM; const bf16_t* orow = OF + (size_t)(m - MP) * DM;
                f32x4 ov[16]; float q = 0.f;
#pragma unroll
                for (int j = 0; j < 16; ++j) { const bf16_t* op = orow + (lane + 64 * j) * 4;
                    const u32x2 p0 = *(const u32x2*)op, p1 = *(const u32x2*)(op + SLAB), p2 = *(const u32x2*)(op + 2 * SLAB), p3 = *(const u32x2*)(op + 3 * SLAB);
                    ov[j][0] = (bflo(p0.x) + bflo(p1.x)) + (bflo(p2.x) + bflo(p3.x)); ov[j][1] = (bfhi(p0.x) + bfhi(p1.x)) + (bfhi(p2.x) + bfhi(p3.x));
                    ov[j][2] = (bflo(p0.y) + bflo(p1.y)) + (bflo(p2.y) + bflo(p3.y)); ov[j][3] = (bfhi(p0.y) + bfhi(p1.y)) + (bfhi(p2.y) + bfhi(p3.y));
                    q += (ov[j][0] * ov[j][0] + ov[j][1] * ov[j][1]) + (ov[j][2] * ov[j][2] + ov[j][3] * ov[j][3]); }
                q = wave_sum(q);
                const float rs = rsqrtf(q * (1.0f / DM) + EPS);
#pragma unroll
                for (int j = 0; j < 16; ++j) {
                    const int c = (lane + 64 * j) * 4;
                    const f32x4 x0 = __builtin_nontemporal_load((const f32x4*)(xr + c)), g0 = *(const f32x4*)(g_post + c);
                    __builtin_nontemporal_store(x0 + ov[j] * rs * g0, (f32x4*)(yr + c));
                }
            }
        }
    }
}

extern "C" void kernel_launch(void* const* d_in, const int* in_sizes, int n_in, void* d_out, int out_size, void* d_ws, size_t ws_size, hipStream_t stream) {
    static int grid = 0;
    if (grid == 0) {
        if (n_in != 22 || ws_size < WS_END) { fprintf(stderr, "kernel_launch: unexpected inputs (n_in %d, ws %zu)\n", n_in, ws_size); grid = -1; return; }
        int dev = 0, cus = 0, per_cu = 0;
        (void)hipGetDevice(&dev);
        (void)hipDeviceGetAttribute(&cus, hipDeviceAttributeMultiprocessorCount, dev);
        if (hipFuncSetAttribute((const void*)mega_fwd, hipFuncAttributeMaxDynamicSharedMemorySize, LDS_BYTES) != hipSuccess) { fprintf(stderr, "kernel_launch: hipFuncSetAttribute failed\n"); grid = -1; return; }
        if (hipOccupancyMaxActiveBlocksPerMultiprocessor(&per_cu, (const void*)mega_fwd, NTHREADS, LDS_BYTES) != hipSuccess || per_cu < 1) { fprintf(stderr, "kernel_launch: occupancy query says %d\n", per_cu); per_cu = 1; }
        (void)hipGetLastError();
        grid = 256;
        if (cus != 256) fprintf(stderr, "kernel_launch: built for a 256-CU device, found %d CUs\n", cus);
    }
    if (grid < 0) return;
    (void)hipMemsetAsync((char*)d_ws + WS_CTL, 0, CTL_BYTES, stream);
    Args a{};
    for (int i = 0; i < 22; ++i) a.in[i] = (const float*)d_in[i];
    a.out = (float*)d_out; a.ws = (unsigned char*)d_ws;
    void* kargs[] = {&a};
    hipError_t e = hipLaunchCooperativeKernel((const void*)mega_fwd, dim3(grid), dim3(NTHREADS), kargs, LDS_BYTES, stream);
    if (e != hipSuccess) fprintf(stderr, "kernel_launch: cooperative launch failed: %s (grid %d)\n", hipGetErrorString(e), grid);
}
```

```cpp
#include <hip/hip_runtime.h>
#include <hip/hip_cooperative_groups.h>
#include <cstdio>
#include <cstdint>
namespace cg = cooperative_groups;

#define LAS __attribute__((address_space(3)))
typedef unsigned short bf16_t;
typedef short bf16x8 __attribute__((ext_vector_type(8)));
typedef short s16x4 __attribute__((ext_vector_type(4)));
typedef float f32x4 __attribute__((ext_vector_type(4)));
typedef unsigned u32x4 __attribute__((ext_vector_type(4)));
typedef unsigned u32x2 __attribute__((ext_vector_type(2)));

constexpr int DM = 4096;
constexpr int MP = 8192, MS = 1024, MT = MP + MS;
constexpr int NIN = 11264;
constexpr int CC = 1536;
constexpr int CX = 1024;
constexpr int MEMR = 512;
constexpr float EPS = 1e-6f;
constexpr int PW = 5120;
constexpr int P_UG = 0, P_SGC = 1536, P_Q = 3072, P_SGX = 4096;
constexpr int GROWS = MT + 18 * 30;
__device__ __forceinline__ int glu_row(int row) { return row < MP ? row + 30 * ((row >> 12) + 1) : row + 30 * (((row - MP) >> 6) + 3); }
constexpr float QSCALE = 0.0625f * 1.4426950408889634f;

constexpr size_t O_Y = 0, O_MK = (size_t)MT * DM, O_MV = O_MK + 524288, O_CP = O_MV + 524288, O_CS = O_CP + 92160, O_GV = O_CS + 737280;

constexpr size_t MiB = 1u << 20;
constexpr size_t WS_CTL = 0, CTL_BYTES = 262144;
constexpr size_t CTL_BAR = 131072;
constexpr size_t CTL_PCNT = 196608;
constexpr size_t CTL_VSTAT = 4096, CTL_OSS = CTL_VSTAT + (size_t)MT * 8;
static_assert(CTL_OSS + (size_t)MT * 4 <= CTL_BYTES, "ctl");
constexpr size_t WS_WT = 2 * MiB;
constexpr size_t WS_WO = 106 * MiB;
constexpr size_t WS_H = 138 * MiB;
constexpr size_t WS_P = 214 * MiB;
constexpr size_t WS_VT = 332 * MiB;
constexpr size_t WS_KB = 360 * MiB;
constexpr size_t WS_VTM = 370 * MiB;
constexpr size_t WS_MIX = 380 * MiB;
constexpr size_t WS_OUT = 452 * MiB;
constexpr size_t WS_GLU = 524 * MiB;
constexpr size_t WS_QF = 556 * MiB;
constexpr size_t WS_OF = 620 * MiB;
constexpr size_t WS_END = 684 * MiB;
constexpr size_t SLAB = (size_t)4096 * 1024;
static_assert(WS_GLU + (size_t)GROWS * CC * 2 <= WS_END, "glu");
static_assert(WS_WT + (size_t)13312 * 4096 * 2 <= WS_WO && WS_WO + (size_t)4096 * 4096 * 2 <= WS_H && WS_H + (size_t)9728 * 4096 * 2 <= WS_P &&
              WS_P + (size_t)MT * PW * 2 <= WS_VT && WS_VT + (size_t)CC * MT * 2 <= WS_KB && WS_KB + (size_t)18 * 256 * 1024 * 2 <= WS_VTM &&
              WS_VTM + (size_t)18 * 1024 * 256 * 2 <= WS_MIX && WS_MIX + (size_t)MT * DM * 2 <= WS_OUT && WS_OUT + (size_t)MT * DM * 2 <= WS_END, "ws map");

constexpr int LDS_BYTES = 143360;
constexpr int NTHREADS = 512;

__device__ __forceinline__ unsigned cvt_pk_bf16(float lo, float hi) { unsigned r; asm volatile("v_cvt_pk_bf16_f32 %0, %1, %2" : "=v"(r) : "v"(lo), "v"(hi)); return r; }
__device__ __forceinline__ bf16_t f2bf(float f) { return (bf16_t)(cvt_pk_bf16(f, 0.f) & 0xffffu); }
__device__ __forceinline__ float bf2f(bf16_t u) { return __uint_as_float(((unsigned)u) << 16); }
__device__ __forceinline__ float bflo(unsigned u) { return __uint_as_float(u << 16); }
__device__ __forceinline__ float bfhi(unsigned u) { return __uint_as_float(u & 0xffff0000u); }
__device__ __forceinline__ float sigmoidf_(float x) { return __builtin_amdgcn_rcpf(1.0f + __builtin_amdgcn_exp2f(-1.4426950408889634f * x)); }
__device__ __forceinline__ float wave_sum(float v) {
#pragma unroll
    for (int o = 1; o < 64; o <<= 1) v += __shfl_xor(v, o);
    return v;
}
#define LDS_WAIT() asm volatile("s_waitcnt lgkmcnt(0)" ::: "memory")
__device__ __forceinline__ int opq(int x) { asm volatile("" : "+v"(x)); return x; }

namespace pg8 {
constexpr int BM = 256, BK = 64, HALF = 128, HTB = HALF * BK * 2, STAGE_BYTES = 8 * HTB;
__device__ __forceinline__ int lds_byte(int r, int c) { const int st = (r >> 4) * 2 + (c >> 5), rr = r & 15, cc = c & 31, ob = rr * 64 + cc * 2; return st * 1024 + (ob ^ (((ob >> 9) & 1) << 5)); }
__device__ __forceinline__ void stage_rc(int b, int& R, int& C) { const int st = b / 1024, sb = b % 1024, swz = sb ^ (((sb >> 9) & 1) << 5); R = (st >> 1) * 16 + swz / 64; C = (st & 1) * 32 + (swz % 64) / 2; }
__device__ __forceinline__ int perm32(int rho) { const int n = rho >> 4, i = rho & 15; return 8 * (i >> 2) + 4 * n + (i & 3); }
struct Unit { int pm, pn, koff, kt; };
struct Gemm { const bf16_t* A; const bf16_t* Bt; int ld; };

template <class Epi, class Sched>
__device__ __forceinline__ void gemm_phase(LAS unsigned char* lds, const Gemm g, const Sched& S, const Epi& E) {
    const int tid = opq((int)threadIdx.x) & 511, wid = __builtin_amdgcn_readfirstlane(tid >> 6), lane = tid & 63, wr = wid >> 2, wc = wid & 3, fr = lane & 15, fq = lane >> 4;
    const int K = g.ld;
    unsigned voffA[2], voffB[2];
#pragma unroll
    for (int i = 0; i < 2; ++i) { int R, C; stage_rc(tid * 16 + i * 8192, R, C); const int Rb = (R & ~31) + perm32(R & 31);
        voffA[i] = (unsigned)(R * K + C) * 2u; voffB[i] = (unsigned)(Rb * K + C) * 2u; }
    const size_t kstep = (size_t)(BK * 2);
    const size_t hstep = (size_t)HALF * K * 2;
    const size_t tstep = 2 * hstep;
    const unsigned ldsw = (unsigned)wid * 1024u;
    const int aoff = lds_byte(wr * 64 + fr, fq * 8), boff = lds_byte(wc * 32 + fr, fq * 8);
#define PG8_SA(b, h) (((b) * 2 + (h)) * HTB)
#define PG8_SB(b, h) ((4 + (b) * 2 + (h)) * HTB)
#define PG8_STAGE(bufoff, gbase, voff) do { _Pragma("unroll") for (int _i = 0; _i < 2; ++_i) \
        __builtin_amdgcn_global_load_lds((const unsigned*)((const char*)(gbase) + (voff)[_i]), (LAS unsigned*)(lds + (bufoff) + ldsw + _i * 8192), 16, 0, 0); } while (0)
#define PG8_LDA(dst, b, h) do { _Pragma("unroll") for (int m = 0; m < 4; ++m) _Pragma("unroll") for (int k = 0; k < 2; ++k) dst[m][k] = *(const LAS bf16x8*)(lds + PG8_SA(b, h) + aoff + m * 2048 + k * 1024); } while (0)
#define PG8_LDB(dst, b, h) do { _Pragma("unroll") for (int n = 0; n < 2; ++n) _Pragma("unroll") for (int k = 0; k < 2; ++k) dst[n][k] = *(const LAS bf16x8*)(lds + PG8_SB(b, h) + boff + n * 2048 + k * 1024); } while (0)
#define PG8_MMA(ai, bj, At, Bt) do { __builtin_amdgcn_s_setprio(1); _Pragma("unroll") for (int m = 0; m < 4; ++m) _Pragma("unroll") for (int n = 0; n < 2; ++n) _Pragma("unroll") for (int k = 0; k < 2; ++k) \
        acc[ai][bj][m][n] = __builtin_amdgcn_mfma_f32_16x16x32_bf16(Bt[n][k], At[m][k], acc[ai][bj][m][n], 0, 0, 0); __builtin_amdgcn_s_setprio(0); } while (0)
#define PG8_WAIT_V(n) asm volatile("s_waitcnt vmcnt(" #n ")" ::: "memory")
#define PG8_WAIT_L(n) asm volatile("s_waitcnt lgkmcnt(" #n ")" ::: "memory")
#define PG8_BAR __builtin_amdgcn_s_barrier()
#define PG8_SCHED __builtin_amdgcn_sched_barrier(0)
    Unit cur, nxt; int ui = 0;
    if (!S.next(0, cur)) return;
    f32x4 acc[2][2][4][2];
#pragma unroll
    for (int a = 0; a < 2; ++a)
#pragma unroll
        for (int b = 0; b < 2; ++b)
#pragma unroll
            for (int m = 0; m < 4; ++m)
#pragma unroll
                for (int n = 0; n < 2; ++n) acc[a][b][m][n] = (f32x4){0.f, 0.f, 0.f, 0.f};
    bf16x8 At[4][2], B0[2][2], B1[2][2];
    const char* cA = (const char*)g.A + (size_t)cur.pm * tstep + (size_t)cur.koff * 2; const char* cB = (const char*)g.Bt + (size_t)cur.pn * tstep + (size_t)cur.koff * 2;
    PG8_STAGE(PG8_SB(0, 0), cB, voffB); PG8_STAGE(PG8_SB(0, 1), cB + hstep, voffB); PG8_STAGE(PG8_SA(0, 0), cA, voffA); PG8_STAGE(PG8_SA(0, 1), cA + hstep, voffA);
    if (wr == 1) PG8_BAR;
    PG8_WAIT_V(2); PG8_BAR;
    PG8_STAGE(PG8_SB(1, 0), cB + kstep, voffB); PG8_STAGE(PG8_SA(1, 0), cA + kstep, voffA); PG8_STAGE(PG8_SB(1, 1), cB + hstep + kstep, voffB);
    PG8_WAIT_V(6); PG8_BAR;
    for (;;) {
        const bool has_next = S.next(ui + 1, nxt);
        const char* nA = has_next ? (const char*)g.A + (size_t)nxt.pm * tstep + (size_t)nxt.koff * 2 : cA; const char* nB = has_next ? (const char*)g.Bt + (size_t)nxt.pn * tstep + (size_t)nxt.koff * 2 : cB;
        const int nt = cur.kt;
        for (int t = 0; t < nt; t += 2) {
            const bool last = (t == nt - 2);
            const char* a1 = cA + (size_t)(t + 1) * kstep;
            const char* a2 = last ? nA : cA + (size_t)(t + 2) * kstep; const char* b2 = last ? nB : cB + (size_t)(t + 2) * kstep;
            const char* a3 = a2 + kstep; const char* b3 = b2 + kstep;
            PG8_LDB(B0, 0, 0); PG8_LDB(B1, 0, 1); PG8_SCHED; PG8_LDA(At, 0, 0); PG8_STAGE(PG8_SA(1, 1), a1 + hstep, voffA);
            PG8_WAIT_V(8); PG8_WAIT_L(0); PG8_BAR; PG8_MMA(0, 0, At, B0); PG8_MMA(0, 1, At, B1); PG8_BAR; PG8_SCHED;
            PG8_LDA(At, 0, 1); PG8_STAGE(PG8_SB(0, 0), b2, voffB); PG8_STAGE(PG8_SB(0, 1), b2 + hstep, voffB); PG8_STAGE(PG8_SA(0, 0), a2, voffA);
            PG8_WAIT_V(8); PG8_WAIT_L(0); PG8_BAR; PG8_MMA(1, 0, At, B0); PG8_MMA(1, 1, At, B1); PG8_BAR; PG8_SCHED;
            PG8_LDB(B0, 1, 0); PG8_LDB(B1, 1, 1); PG8_SCHED; PG8_LDA(At, 1, 0); PG8_STAGE(PG8_SA(0, 1), a2 + hstep, voffA);
            PG8_WAIT_V(8); PG8_WAIT_L(0); PG8_BAR; PG8_MMA(0, 0, At, B0); PG8_MMA(0, 1, At, B1); PG8_BAR; PG8_SCHED;
            PG8_LDA(At, 1, 1); PG8_STAGE(PG8_SB(1, 0), b3, voffB); PG8_STAGE(PG8_SB(1, 1), b3 + hstep, voffB); PG8_STAGE(PG8_SA(1, 0), a3, voffA);
            PG8_WAIT_V(8); PG8_WAIT_L(0); PG8_BAR; PG8_MMA(1, 0, At, B0); PG8_MMA(1, 1, At, B1); PG8_BAR; PG8_SCHED;
        }
        if (wr == 0) PG8_BAR;
        E(acc, cur, wr, wc, fr, fq);
        if (!has_next) break;
#pragma unroll
        for (int a = 0; a < 2; ++a)
#pragma unroll
            for (int b = 0; b < 2; ++b)
#pragma unroll
                for (int m = 0; m < 4; ++m)
#pragma unroll
                    for (int n = 0; n < 2; ++n) acc[a][b][m][n] = (f32x4){0.f, 0.f, 0.f, 0.f};
        cur = nxt; cA = nA; cB = nB; ++ui;
        if (wr == 1) PG8_BAR;
    }
    PG8_WAIT_V(0);
    PG8_BAR;
#undef PG8_SA
#undef PG8_SB
#undef PG8_STAGE
#undef PG8_LDA
#undef PG8_LDB
#undef PG8_MMA
#undef PG8_WAIT_V
#undef PG8_WAIT_L
#undef PG8_BAR
#undef PG8_SCHED
}
}

__device__ __forceinline__ void static_unit(int L, int nM, int nN, pg8::Unit& u) {
    const int nwg = nM * nN;
    int wgid = L; { const int q = nwg / 8, r = nwg % 8, xcd = wgid % 8, off = wgid / 8; wgid = (xcd < r ? xcd * (q + 1) : r * (q + 1) + (xcd - r) * q) + off; }
    const int nig = 8 * nN, gid = wgid / nig, fm = gid * 8, gsz = (nM - fm) < 8 ? (nM - fm) : 8;
    u.pm = fm + ((wgid % nig) % gsz); u.pn = (wgid % nig) / gsz; u.koff = 0; u.kt = 64;
}
__device__ __forceinline__ void g1_full_unit(int L, pg8::Unit& u) {
    pg8::Unit t; static_unit(L < 1440 ? L : 0, 36, 40, t); if (t.pn >= 36) t.pn += 4;
    const int r = L - 1440; const bool tail = L >= 1440, isq = r < 80;
    u.pm = tail ? (isq ? 16 + (r >> 2) : 36 + ((r - 80) >> 3)) : t.pm; u.pn = tail ? (isq ? 36 + (r & 3) : 44 + ((r - 80) & 7)) : t.pn; u.koff = 0; u.kt = 64;
}
struct Sched1 {
    int c;
    __device__ __forceinline__ bool next(int i, pg8::Unit& u) const {
        if (i >= 7) return false;
        const bool qfirst = (c & 4) != 0; const bool isq = (i == (qfirst ? 0 : 6));
        pg8::Unit f; g1_full_unit((qfirst ? (i > 0 ? i - 1 : 0) : (i < 6 ? i : 0)) * 256 + c, f);
        const int xcd = c & 7, j = c >> 3;
        u.pm = isq ? 2 * xcd + (j >> 4) : f.pm; u.pn = isq ? 36 + ((j & 15) >> 2) : f.pn; u.koff = isq ? 1024 * (j & 3) : 0; u.kt = isq ? 16 : 64;
        return true;
    }
};
struct Sched2 {
    int c;
    __device__ __forceinline__ bool next(int i, pg8::Unit& u) const {
        if (i >= 3) return false;
        const bool qfirst = (c & 4) != 0; const bool isq = (i == (qfirst ? 0 : 2));
        const int xcd = c & 7, j = c >> 3, r = qfirst ? i - 1 : i;
        u.pm = isq ? 32 + (xcd >> 1) : 16 * r + 2 * xcd + (j >> 4); u.pn = j & 15; u.koff = isq ? 1024 * (2 * (xcd & 1) + (j >> 4)) : 0; u.kt = isq ? 16 : 64;
        return true;
    }
};

struct Epi1 {
    bf16_t* P; bf16_t* GLU; bf16_t* VT; float* vstat; float* out; bf16_t* KB; bf16_t* VTM;
    __device__ __forceinline__ void operator()(const f32x4 (&acc)[2][2][4][2], const pg8::Unit& u, int wr, int wc, int fr, int fq) const {
        asm volatile("" : "+v"(fr), "+v"(fq));
        const int pm = u.pm, pn = u.pn;
        const int rb = pm * 256 + wr * 64 + fr;
        const int cl = wc * 32 + 8 * fq;
        if (pn < 24) {
            const bool isglu = pn < 12; const int t = isglu ? pn : pn - 12;
            bf16_t* base = (isglu ? GLU : P + P_UG) + t * 128 + cl;
#pragma unroll
            for (int ai = 0; ai < 2; ++ai)
#pragma unroll
                for (int m = 0; m < 4; ++m) {
                    const int row = rb + ai * 128 + m * 16;
                    f32x4 r0, r1; const f32x4 x0 = acc[ai][0][m][0], x1 = acc[ai][0][m][1], g0 = acc[ai][1][m][0], g1 = acc[ai][1][m][1];
#pragma unroll
                    for (int j = 0; j < 4; ++j) {
                        float s0 = sigmoidf_(g0[j]), s1 = sigmoidf_(g1[j]);
                        if (!isglu) { s0 *= g0[j]; s1 *= g1[j]; }
                        r0[j] = x0[j] * s0; r1[j] = x1[j] * s1;
                    }
                    u32x4 w; w.x = cvt_pk_bf16(r0[0], r0[1]); w.y = cvt_pk_bf16(r0[2], r0[3]); w.z = cvt_pk_bf16(r1[0], r1[1]); w.w = cvt_pk_bf16(r1[2], r1[3]);
                    *(u32x4*)(base + (isglu ? (size_t)glu_row(row) * CC : (size_t)row * PW)) = w;
                    if (isglu) {
                        float* dst = nullptr;
                        if (row < MP) { const int tt = row & 4095; if (tt >= 4066) dst = out + O_CP + ((size_t)(row >> 12) * 30 + (tt - 4066)) * CC; }
                        else { const int rr = row - MP, tt = rr & 63; if (tt >= 34) dst = out + O_CS + ((size_t)(rr >> 6) * 30 + (tt - 34)) * CC; }
                        if (dst) { dst += t * 128 + cl; *(f32x4*)dst = r0; *(f32x4*)(dst + 4) = r1; }
                    }
                }
        } else if (pn < 30 || (pn >= 36 && pn < 44)) {
            int cb; bool act = true;
            if (pn < 30) cb = P_SGC + (pn - 24) * 256; else if (pn < 40) { cb = P_Q + (pn - 36) * 256; act = false; } else cb = P_SGX + (pn - 40) * 256;
            bf16_t* base = P + cb + cl;
#pragma unroll
            for (int ai = 0; ai < 2; ++ai)
#pragma unroll
                for (int m = 0; m < 4; ++m) {
                    const int row = rb + ai * 128 + m * 16;
#pragma unroll
                    for (int bj = 0; bj < 2; ++bj) {
                        f32x4 v0 = acc[ai][bj][m][0], v1 = acc[ai][bj][m][1];
#pragma unroll
                        for (int j = 0; j < 4; ++j) {
                            if (act) { v0[j] *= sigmoidf_(v0[j]); v1[j] *= sigmoidf_(v1[j]); } else { v0[j] *= QSCALE; v1[j] *= QSCALE; }
                        }
                        u32x4 w; w.x = cvt_pk_bf16(v0[0], v0[1]); w.y = cvt_pk_bf16(v0[2], v0[3]); w.z = cvt_pk_bf16(v1[0], v1[1]); w.w = cvt_pk_bf16(v1[2], v1[3]);
                        *(u32x4*)(base + (size_t)row * PW + bj * 128) = w;
                    }
                }
        } else if (pn < 36) {
            const int c0 = (pn - 30) * 256 + cl;
#pragma unroll
            for (int ai = 0; ai < 2; ++ai)
#pragma unroll
                for (int m = 0; m < 4; ++m) {
                    const int row = rb + ai * 128 + m * 16;
                    float s = 0.f, q = 0.f;
#pragma unroll
                    for (int bj = 0; bj < 2; ++bj)
#pragma unroll
                        for (int n = 0; n < 2; ++n) {
                            const f32x4 v = acc[ai][bj][m][n];
#pragma unroll
                            for (int j = 0; j < 4; ++j) { s += v[j]; q += v[j] * v[j]; VT[(size_t)(c0 + bj * 128 + 4 * n + j) * MT + row] = f2bf(v[j]); }
                        }
                    s += __shfl_xor(s, 16); s += __shfl_xor(s, 32); q += __shfl_xor(q, 16); q += __shfl_xor(q, 32);
                    if (fq == 0) { atomicAdd(vstat + 2 * row, s); atomicAdd(vstat + 2 * row + 1, q); }
                    if (row >= MP) {
                        float* dst = out + O_GV + (size_t)(row - MP) * CC + c0;
#pragma unroll
                        for (int bj = 0; bj < 2; ++bj) { *(f32x4*)(dst + bj * 128) = acc[ai][bj][m][0]; *(f32x4*)(dst + bj * 128 + 4) = acc[ai][bj][m][1]; }
                    }
                }
        } else {
            const int b = pm - 36, hh = (pn - 44) & 3; const bool isv = pn >= 48;
            float* fo = out + (isv ? O_MV : O_MK);
#pragma unroll
            for (int ai = 0; ai < 2; ++ai)
#pragma unroll
                for (int m = 0; m < 4; ++m) {
                    const int mr = wr * 64 + fr + ai * 128 + m * 16;
                    const size_t rowg = (size_t)b * 256 + mr;
#pragma unroll
                    for (int bj = 0; bj < 2; ++bj) {
                        const f32x4 v0 = acc[ai][bj][m][0], v1 = acc[ai][bj][m][1];
                        const int d0 = bj * 128 + cl;
                        float* dst = fo + rowg * 1024 + hh * 256 + d0; *(f32x4*)dst = v0; *(f32x4*)(dst + 4) = v1;
                        if (!isv) {
                            u32x4 w; w.x = cvt_pk_bf16(v0[0], v0[1]); w.y = cvt_pk_bf16(v0[2], v0[3]); w.z = cvt_pk_bf16(v1[0], v1[1]); w.w = cvt_pk_bf16(v1[2], v1[3]);
                            *(u32x4*)(KB + rowg * 1024 + hh * 256 + d0) = w;
                        } else {
#pragma unroll
                            for (int j = 0; j < 4; ++j) { VTM[((size_t)(b * 4 + hh) * 256 + d0 + j) * 256 + mr] = f2bf(v0[j]); VTM[((size_t)(b * 4 + hh) * 256 + d0 + 4 + j) * 256 + mr] = f2bf(v1[j]); }
                        }
                    }
                }
        }
    }
};

struct Epi2F {
    const float* xp; const float* gpost; float* y; float* oss; unsigned* cnt;
    __device__ __forceinline__ void operator()(const f32x4 (&acc)[2][2][4][2], const pg8::Unit& u, int wr, int wc, int fr, int fq) const {
        asm volatile("" : "+v"(fr), "+v"(fq));
        const int rb = u.pm * 256 + wr * 64 + fr;
#pragma unroll
        for (int ai = 0; ai < 2; ++ai)
#pragma unroll
            for (int m = 0; m < 4; ++m) {
                float q = 0.f;
#pragma unroll
                for (int bj = 0; bj < 2; ++bj) {
                    const f32x4 v0 = acc[ai][bj][m][0], v1 = acc[ai][bj][m][1];
                    q += (v0[0] * v0[0] + v0[1] * v0[1]) + (v0[2] * v0[2] + v0[3] * v0[3]) + (v1[0] * v1[0] + v1[1] * v1[1]) + (v1[2] * v1[2] + v1[3] * v1[3]);
                }
                q += __shfl_xor(q, 16); q += __shfl_xor(q, 32);
                if (fq == 0) (void)__hip_atomic_fetch_add(oss + rb + ai * 128 + m * 16, q, __ATOMIC_RELAXED, __HIP_MEMORY_SCOPE_AGENT);
            }
        const int c0 = u.pn * 256 + wc * 32 + 8 * fq;
        f32x4 gp[2][2];
#pragma unroll
        for (int bj = 0; bj < 2; ++bj) { gp[bj][0] = *(const f32x4*)(gpost + c0 + bj * 128); gp[bj][1] = *(const f32x4*)(gpost + c0 + bj * 128 + 4); }
        f32x4 pre[2][2][2];
#pragma unroll
        for (int m = 0; m < 2; ++m)
#pragma unroll
            for (int bj = 0; bj < 2; ++bj) { const size_t off = (size_t)(rb + m * 16) * DM + c0 + bj * 128; pre[m][bj][0] = __builtin_nontemporal_load((const f32x4*)(xp + off)); pre[m][bj][1] = __builtin_nontemporal_load((const f32x4*)(xp + off + 4)); }
        asm volatile("s_waitcnt vmcnt(0)" ::: "memory");
        __builtin_amdgcn_s_barrier();
        if (threadIdx.x == 0) {
            unsigned* cw = cnt + 64 * u.pm;
            (void)__hip_atomic_fetch_add(cw, 1u, __ATOMIC_RELAXED, __HIP_MEMORY_SCOPE_AGENT);
            unsigned sp = 0;
            while (__hip_atomic_load(cw, __ATOMIC_RELAXED, __HIP_MEMORY_SCOPE_AGENT) < 16u) { __builtin_amdgcn_s_sleep(2); if (++sp > (1u << 22)) break; }
        }
        __builtin_amdgcn_s_barrier();
        asm volatile("" ::: "memory");
#pragma unroll
        for (int ai = 0; ai < 2; ++ai)
#pragma unroll
            for (int m = 0; m < 4; ++m) {
                const int row = rb + ai * 128 + m * 16;
                const float tot = __hip_atomic_load(oss + row, __ATOMIC_RELAXED, __HIP_MEMORY_SCOPE_AGENT);
                const float rs = rsqrtf(tot * (1.0f / DM) + EPS);
#pragma unroll
                for (int bj = 0; bj < 2; ++bj) {
                    const size_t off = (size_t)row * DM + c0 + bj * 128;
                    const f32x4 x0 = (ai == 0 && m < 2) ? pre[m & 1][bj][0] : __builtin_nontemporal_load((const f32x4*)(xp + off)), x1 = (ai == 0 && m < 2) ? pre[m & 1][bj][1] : __builtin_nontemporal_load((const f32x4*)(xp + off + 4));
                    __builtin_nontemporal_store(x0 + acc[ai][bj][m][0] * rs * gp[bj][0], (f32x4*)(y + off)); __builtin_nontemporal_store(x1 + acc[ai][bj][m][1] * rs * gp[bj][1], (f32x4*)(y + off + 4));
                }
            }
    }
};
struct EpiSlab {
    bf16_t* F; int ldf, pm0, pn0; size_t slab;
    __device__ __forceinline__ void operator()(const f32x4 (&acc)[2][2][4][2], const pg8::Unit& u, int wr, int wc, int fr, int fq) const {
        asm volatile("" : "+v"(fr), "+v"(fq));
        const int rb = (u.pm - pm0) * 256 + wr * 64 + fr;
        bf16_t* base = F + (size_t)(u.koff >> 10) * slab + (u.pn - pn0) * 256 + wc * 32 + 8 * fq;
#pragma unroll
        for (int ai = 0; ai < 2; ++ai)
#pragma unroll
            for (int m = 0; m < 4; ++m) {
                bf16_t* rp = base + (size_t)(rb + ai * 128 + m * 16) * ldf;
#pragma unroll
                for (int bj = 0; bj < 2; ++bj) { const f32x4 v0 = acc[ai][bj][m][0], v1 = acc[ai][bj][m][1];
                    u32x4 w; w.x = cvt_pk_bf16(v0[0], v0[1]); w.y = cvt_pk_bf16(v0[2], v0[3]); w.z = cvt_pk_bf16(v1[0], v1[1]); w.w = cvt_pk_bf16(v1[2], v1[3]);
                    *(u32x4*)(rp + bj * 128) = w; }
            }
    }
};

template <class EF>
struct EpiMix {
    EF f; EpiSlab q;
    __device__ __forceinline__ void operator()(const f32x4 (&acc)[2][2][4][2], const pg8::Unit& u, int wr, int wc, int fr, int fq) const {
        if (u.kt == 64) f(acc, u, wr, wc, fr, fq); else q(acc, u, wr, wc, fr, fq);
    }
};

__device__ __forceinline__ void transpose_item64(const float* __restrict__ W, int N, bf16_t* __restrict__ WT, int K, int k0, int n0, int drow0, LAS float* scr, int lane) {
    const int lr = lane >> 4, lc = (lane & 15) * 4;
    f32x4 v[16];
#pragma unroll
    for (int i = 0; i < 16; ++i) v[i] = __builtin_nontemporal_load((const f32x4*)(W + (size_t)(k0 + 4 * i + lr) * N + n0 + lc));
#pragma unroll
    for (int i = 0; i < 16; ++i) { LAS float* p = scr + (4 * i + lr) * 65 + lc; p[0] = v[i][0]; p[1] = v[i][1]; p[2] = v[i][2]; p[3] = v[i][3]; }
    LDS_WAIT();
    const int c = lane & 7, nr = lane >> 3;
#pragma unroll
    for (int j = 0; j < 8; ++j) {
        const int n = nr + 8 * j; const LAS float* s = scr + (8 * c) * 65 + n;
        u32x4 o; o.x = cvt_pk_bf16(s[0], s[65]); o.y = cvt_pk_bf16(s[130], s[195]); o.z = cvt_pk_bf16(s[260], s[325]); o.w = cvt_pk_bf16(s[390], s[455]);
        *(u32x4*)(WT + (size_t)(drow0 + n0 + n) * K + k0 + 8 * c) = o;
    }
    LDS_WAIT();
}
__device__ __forceinline__ int win_dest_row(int n) {
    if (n < 1536) return 256 * (n >> 7) + (n & 127);
    if (n < 3072) { n -= 1536; return 256 * (n >> 7) + 128 + (n & 127); }
    if (n < 4608) return 256 * 24 + (n - 3072);
    if (n < 6144) { n -= 4608; return 256 * (12 + (n >> 7)) + (n & 127); }
    if (n < 7680) return 256 * 30 + (n - 6144);
    if (n < 9216) { n -= 7680; return 256 * (12 + (n >> 7)) + 128 + (n & 127); }
    if (n < 10240) return 256 * 36 + (n - 9216);
    return 256 * 40 + (n - 10240);
}
__device__ __forceinline__ void rms_row_bf16(const float* __restrict__ xrow, const float* __restrict__ g, bf16_t* __restrict__ orow, int lane) {
    f32x4 v[16]; float s = 0.f;
#pragma unroll
    for (int j = 0; j < 16; ++j) { v[j] = __builtin_nontemporal_load((const f32x4*)xrow + lane + 64 * j); s += (v[j][0] * v[j][0] + v[j][1] * v[j][1]) + (v[j][2] * v[j][2] + v[j][3] * v[j][3]); }
    s = wave_sum(s);
    const float r = rsqrtf(s * (1.0f / DM) + EPS);
#pragma unroll
    for (int j = 0; j < 16; ++j) {
        const f32x4 gg = ((const f32x4*)g)[lane + 64 * j];
        u32x2 o; o.x = cvt_pk_bf16(v[j][0] * r * gg[0], v[j][1] * r * gg[1]); o.y = cvt_pk_bf16(v[j][2] * r * gg[2], v[j][3] * r * gg[3]);
        ((u32x2*)orow)[lane + 64 * j] = o;
    }
}

#define XB_TMO      128
#define XB_XCNT(j)  (256  + 64 * (j))
#define XB_XSUB(j)  (1280 + 64 * (j))
#define XB_XGEN(j)  (2304 + 64 * (j))
#define XB_TOP      3328
#define XB_TOPGEN   3392
#define XB_SPIN_CAP (1u << 20)
__device__ __forceinline__ unsigned xb_ld(unsigned* p)              { return __hip_atomic_load(p, __ATOMIC_RELAXED, __HIP_MEMORY_SCOPE_AGENT); }
__device__ __forceinline__ unsigned xb_add(unsigned* p, unsigned v) { return __hip_atomic_fetch_add(p, v, __ATOMIC_RELAXED, __HIP_MEMORY_SCOPE_AGENT); }
__device__ __forceinline__ unsigned xb_xcc_id() { return (unsigned)__builtin_amdgcn_s_getreg((3 << 11) | 20) & 0xFu; }
#define XB_SPIN(cond, bar) do { unsigned _sp = 0; while (cond) { __builtin_amdgcn_s_sleep(1); \
    if ((++_sp & 255u) == 0u) { if (xb_ld(&(bar)[XB_TMO])) break; if (_sp > XB_SPIN_CAP) { atomicAdd(&(bar)[XB_TMO], 1u); break; } } } } while (0)
struct XcdBarrier { unsigned* bar; unsigned x; volatile LAS unsigned* st; };
__device__ __forceinline__ XcdBarrier xcd_barrier_post(unsigned* bar, volatile LAS unsigned* st) {
    XcdBarrier b; b.bar = bar; b.x = xb_xcc_id(); b.st = st;
    if (threadIdx.x == 0) (void)xb_add(&bar[XB_XCNT(b.x)], 1u);
    return b;
}
__device__ __forceinline__ void xcd_barrier_complete(unsigned* bar, unsigned x, unsigned& nloc, unsigned& nx) {
    const unsigned G = gridDim.x * gridDim.y * gridDim.z;
    unsigned sum, cnt, mine, sp = 0u;
    for (;;) {
        sum = 0u; cnt = 0u; mine = 0u;
#pragma unroll
        for (unsigned j = 0; j < 16; ++j) { const unsigned c = xb_ld(&bar[XB_XCNT(j)]); sum += c; cnt += (c > 0u) ? 1u : 0u; mine = (j == x) ? c : mine; }
        if (sum == G) break;
        __builtin_amdgcn_s_sleep(1);
        if ((++sp & 255u) == 0u) { if (xb_ld(&bar[XB_TMO])) break; if (sp > XB_SPIN_CAP) { atomicAdd(&bar[XB_TMO], 1u); break; } }
    }
    nloc = mine > 0u ? mine : 1u; nx = cnt > 0u ? cnt : 1u;
}
__device__ __forceinline__ void xcd_barrier(const XcdBarrier& b) {
    asm volatile("s_waitcnt vmcnt(0)" ::: "memory");
    __syncthreads();
    if (threadIdx.x == 0) {
        unsigned* bar = b.bar;
        __builtin_amdgcn_s_waitcnt(0);
        unsigned nloc = b.st[0], nx = b.st[1];
        if (nloc == 0u) { xcd_barrier_complete(bar, b.x, nloc, nx); b.st[0] = nloc; b.st[1] = nx; }
        const unsigned old = xb_add(&bar[XB_XSUB(b.x)], 1u);
        const unsigned gen = old / nloc;
        if (old + 1u == (gen + 1u) * nloc) {
            __builtin_amdgcn_fence(__ATOMIC_RELEASE, "agent");
            asm volatile("s_waitcnt vmcnt(0)" ::: "memory");
            const unsigned og = xb_add(&bar[XB_TOP], 1u);
            const unsigned tg = og / nx;
            if (og + 1u == (tg + 1u) * nx) xb_add(&bar[XB_TOPGEN], 1u);
            else XB_SPIN(xb_ld(&bar[XB_TOPGEN]) == tg, bar);
            __builtin_amdgcn_fence(__ATOMIC_ACQUIRE, "agent");
            xb_add(&bar[XB_XGEN(b.x)], 1u);
            asm volatile("s_waitcnt vmcnt(0)" ::: "memory");
        } else {
            XB_SPIN(xb_ld(&bar[XB_XGEN(b.x)]) == gen, bar);
            __builtin_amdgcn_fence(__ATOMIC_ACQUIRE, "agent");
            asm volatile("s_waitcnt vmcnt(0)" ::: "memory");
        }
    }
    __syncthreads();
}

struct Args {
    const float* in[22]; float* out; unsigned char* ws;
};

constexpr int KVB = 512;
__device__ __forceinline__ int kv_off(int row, int chunk) { return row * KVB + ((chunk ^ ((row & 15) ^ (((row >> 4) & 1) << 2))) << 4); }
constexpr int KVH = 128 * KVB;
__device__ __forceinline__ void attn_dma(const bf16_t* base, int pitch, LAS unsigned char* buf, int wave, int lane) {
#pragma unroll
    for (int i = 0; i < 8; ++i) {
        const int r = 2 * (8 * wave + i) + (lane >> 5), cs = lane & 31, cg = cs ^ ((r & 15) ^ (((r >> 4) & 1) << 2));
        __builtin_amdgcn_global_load_lds((const unsigned*)(base + (size_t)r * pitch + cg * 8), (LAS unsigned*)(buf + (8 * wave + i) * 1024), 16, 0, 0);
    }
}
#define ATTN_LAND() do { asm volatile("s_waitcnt vmcnt(0)" ::: "memory"); __syncthreads(); } while (0)
__device__ __forceinline__ float attn_epi8(const f32x4 (&o)[8], float inv, const bf16_t* P, bf16_t* MIX, int qrow, int c0, int g) {
    float ss = 0.f;
#pragma unroll
    for (int p = 0; p < 4; ++p) {
        const int c = c0 + 32 * p + 8 * g;
        const u32x4 sg = *(const u32x4*)(P + (size_t)qrow * PW + P_SGX + c);
        f32x4 y0 = o[2 * p] * inv, y1 = o[2 * p + 1] * inv;
        y0[0] *= bflo(sg.x); y0[1] *= bfhi(sg.x); y0[2] *= bflo(sg.y); y0[3] *= bfhi(sg.y);
        y1[0] *= bflo(sg.z); y1[1] *= bfhi(sg.z); y1[2] *= bflo(sg.w); y1[3] *= bfhi(sg.w);
        ss += ((y0[0] * y0[0] + y0[1] * y0[1]) + (y0[2] * y0[2] + y0[3] * y0[3])) + ((y1[0] * y1[0] + y1[1] * y1[1]) + (y1[2] * y1[2] + y1[3] * y1[3]));
        u32x4 w; w.x = cvt_pk_bf16(y0[0], y0[1]); w.y = cvt_pk_bf16(y0[2], y0[3]); w.z = cvt_pk_bf16(y1[0], y1[1]); w.w = cvt_pk_bf16(y1[2], y1[3]);
        *(u32x4*)(MIX + (size_t)qrow * DM + 3072 + c) = w;
    }
    return ss;
}
__device__ __forceinline__ void attn_unit(int a, const bf16_t* P, const bf16_t* QF, const bf16_t* KB, const bf16_t* VTM, const float* g_branch,
                                          bf16_t* MIX, LAS unsigned char* kv, int tid, int wave, int lane) {
    int row0, bm, nq;
    if (a < 64) { row0 = a * 128; bm = a >> 5; nq = 8; } else { row0 = MP + (a - 64) * 64; bm = 2 + (a - 64); nq = 4; }
    const bool active = wave < nq;
    const int l150 = lane & 15, g0 = lane >> 4, l15 = l150, g = g0;
    const int qrow = row0 + 16 * (active ? wave : 0) + l15;
    const bf16_t* kg = KB + (size_t)(bm * 256) * 1024;
    const bf16_t* vg = VTM + (size_t)(bm * 4) * 256 * 256;
    const int krow0 = 8 * (l15 >> 2) + (l15 & 3);
    LAS unsigned char* bufA = kv; LAS unsigned char* bufB = kv + KVH;
    attn_dma(kg, 1024, bufA, wave, opq(lane));
    ATTN_LAND();
    float ss = 0.f;
#pragma unroll 1
    for (int h = 0; h < 4; ++h) {
        attn_dma(kg + h * 256 + (size_t)128 * 1024, 1024, bufB, wave, opq(lane));
        bf16x8 qf[8];
        if (active) {
            if (row0 < 4096) {
#pragma unroll
                for (int ks = 0; ks < 8; ++ks) {
                    const bf16_t* qp = QF + (size_t)qrow * CX + h * 256 + 32 * ks + 8 * g;
                    const u32x4 p0 = *(const u32x4*)qp, p1 = *(const u32x4*)(qp + SLAB), p2 = *(const u32x4*)(qp + 2 * SLAB), p3 = *(const u32x4*)(qp + 3 * SLAB);
                    u32x4 w;
#pragma unroll
                    for (int e = 0; e < 4; ++e) w[e] = cvt_pk_bf16(((bflo(p0[e]) + bflo(p1[e])) + (bflo(p2[e]) + bflo(p3[e]))) * QSCALE, ((bfhi(p0[e]) + bfhi(p1[e])) + (bfhi(p2[e]) + bfhi(p3[e]))) * QSCALE);
                    qf[ks] = __builtin_bit_cast(bf16x8, w);
                }
            } else {
#pragma unroll
                for (int ks = 0; ks < 8; ++ks) qf[ks] = *(const bf16x8*)(P + (size_t)qrow * PW + P_Q + h * 256 + 32 * ks + 8 * g);
            }
        }
        f32x4 s[16];
        if (active) {
            const int krow = opq(krow0), g = opq(g0);
#pragma unroll
            for (int kt = 0; kt < 16; ++kt) s[kt] = (f32x4){0.f, 0.f, 0.f, 0.f};
#pragma unroll
            for (int ks = 0; ks < 8; ++ks)
                {
#pragma unroll
                  for (int kt = 0; kt < 8; ++kt) s[kt] = __builtin_amdgcn_mfma_f32_16x16x32_bf16(*(const LAS bf16x8*)(bufA + kv_off(32 * (kt >> 1) + 4 * (kt & 1) + krow, 4 * ks + g)), qf[ks], s[kt], 0, 0, 0);
                  __builtin_amdgcn_sched_barrier(0); }
        }
        ATTN_LAND();
        attn_dma(vg + (size_t)h * 256 * 256, 256, bufA, wave, opq(lane));
        bf16x8 pf[8]; float inv = 0.f;
        if (active) {
            const int krow = opq(krow0), g = opq(g0);
#pragma unroll
            for (int ks = 0; ks < 8; ++ks)
                {
#pragma unroll
                  for (int kt = 8; kt < 16; ++kt) s[kt] = __builtin_amdgcn_mfma_f32_16x16x32_bf16(*(const LAS bf16x8*)(bufB + kv_off(32 * ((kt - 8) >> 1) + 4 * (kt & 1) + krow, 4 * ks + g)), qf[ks], s[kt], 0, 0, 0);
                  __builtin_amdgcn_sched_barrier(0); }
            float mx = s[0][0];
#pragma unroll
            for (int kt = 0; kt < 16; ++kt)
#pragma unroll
                for (int j = 0; j < 4; ++j) mx = fmaxf(mx, s[kt][j]);
            mx = fmaxf(mx, __shfl_xor(mx, 16)); mx = fmaxf(mx, __shfl_xor(mx, 32));
            float l = 0.f;
#pragma unroll
            for (int kt = 0; kt < 16; ++kt)
#pragma unroll
                for (int j = 0; j < 4; ++j) { const float p = __builtin_amdgcn_exp2f(s[kt][j] - mx); s[kt][j] = p; l += p; }
            l += __shfl_xor(l, 16); l += __shfl_xor(l, 32);
            inv = 1.0f / l;
#pragma unroll
            for (int si = 0; si < 8; ++si) {
                u32x4 w; w.x = cvt_pk_bf16(s[2 * si][0], s[2 * si][1]); w.y = cvt_pk_bf16(s[2 * si][2], s[2 * si][3]);
                w.z = cvt_pk_bf16(s[2 * si + 1][0], s[2 * si + 1][1]); w.w = cvt_pk_bf16(s[2 * si + 1][2], s[2 * si + 1][3]);
                pf[si] = __builtin_bit_cast(bf16x8, w);
            }
        }
        ATTN_LAND();
        attn_dma(vg + (size_t)h * 256 * 256 + (size_t)128 * 256, 256, bufB, wave, opq(lane));
        if (active) {
            const int krow = opq(krow0), g = opq(g0);
            f32x4 o[8];
#pragma unroll
            for (int dt = 0; dt < 8; ++dt) o[dt] = (f32x4){0.f, 0.f, 0.f, 0.f};
#pragma unroll
            for (int si = 0; si < 8; ++si)
                {
#pragma unroll
                  for (int dt = 0; dt < 8; ++dt) o[dt] = __builtin_amdgcn_mfma_f32_16x16x32_bf16(*(const LAS bf16x8*)(bufA + kv_off(32 * (dt >> 1) + 4 * (dt & 1) + krow, 4 * si + g)), pf[si], o[dt], 0, 0, 0);
                  __builtin_amdgcn_sched_barrier(0); }
            ss += attn_epi8(o, inv, P, MIX, qrow, h * 256, g);
        }
        ATTN_LAND();
        if (h < 3) attn_dma(kg + (h + 1) * 256, 1024, bufA, wave, opq(lane));
        if (active) {
            const int krow = opq(krow0), g = opq(g0);
            f32x4 o[8];
#pragma unroll
            for (int dt = 0; dt < 8; ++dt) o[dt] = (f32x4){0.f, 0.f, 0.f, 0.f};
#pragma unroll
            for (int si = 0; si < 8; ++si)
                {
#pragma unroll
                  for (int dt = 0; dt < 8; ++dt) o[dt] = __builtin_amdgcn_mfma_f32_16x16x32_bf16(*(const LAS bf16x8*)(bufB + kv_off(32 * (dt >> 1) + 4 * (dt & 1) + krow, 4 * si + g)), pf[si], o[dt], 0, 0, 0);
                  __builtin_amdgcn_sched_barrier(0); }
            ss += attn_epi8(o, inv, P, MIX, qrow, h * 256 + 128, g);
        }
        ATTN_LAND();
    }
    if (active) {
        ss += __shfl_xor(ss, 16); ss += __shfl_xor(ss, 32);
        const float rs = rsqrtf(ss * (1.0f / CX) + EPS);
        asm volatile("s_waitcnt vmcnt(0)" ::: "memory");
#pragma unroll 1
        for (int b = 0; b < 4; ++b) {
            bf16_t* mp = MIX + (size_t)qrow * DM + 3072 + 256 * b + 8 * g;
            u32x4 yv[8];
#pragma unroll
            for (int i = 0; i < 8; ++i) yv[i] = *(const u32x4*)(mp + 32 * i);
#pragma unroll
            for (int i = 0; i < 8; ++i) {
                const float* gp = g_branch + 3072 + 256 * b + 32 * i + 8 * g;
                const f32x4 g0v = *(const f32x4*)gp, g1v = *(const f32x4*)(gp + 4);
                u32x4 w; w.x = cvt_pk_bf16(bflo(yv[i].x) * rs * g0v[0], bfhi(yv[i].x) * rs * g0v[1]); w.y = cvt_pk_bf16(bflo(yv[i].y) * rs * g0v[2], bfhi(yv[i].y) * rs * g0v[3]);
                w.z = cvt_pk_bf16(bflo(yv[i].z) * rs * g1v[0], bfhi(yv[i].z) * rs * g1v[1]); w.w = cvt_pk_bf16(bflo(yv[i].w) * rs * g1v[2], bfhi(yv[i].w) * rs * g1v[3]);
                *(u32x4*)(mp + 32 * i) = w;
            }
        }
    }
    __syncthreads();
}

__device__ __forceinline__ void gmlp_unit(int u, const bf16_t* P, const bf16_t* VT, const float* vstat, const float* Ws, const float* bsp,
                                          const float* lvg, const float* lvb, const float* g_branch, float* GV, bf16_t* MIX,
                                          LAS float* sm, int tid, int wave, int lane) {
    int row0, ib; bool sample;
    if (u < 512) { row0 = (u >> 3) * 128; ib = u & 7; sample = false; } else { const int v = u - 512; row0 = MP + (v >> 2) * 64; ib = v & 3; sample = true; }
    const int i0 = 16 * ib, nks = (i0 + 47) >> 5, nj = i0 + 16;
    LAS float* sm_mean = sm; LAS float* sm_rstd = sm + 128; LAS float* sm_part = sm + 256;
    if (tid < 128) {
        float mean = 0.f, rstd = 0.f;
        if (tid < nj) { const float s1 = vstat[2 * (row0 + tid)], s2 = vstat[2 * (row0 + tid) + 1]; mean = s1 * (1.0f / CC); const float var = fmaxf(s2 * (1.0f / CC) - mean * mean, 0.f); rstd = rsqrtf(var + EPS); }
        sm_mean[tid] = mean; sm_rstd[tid] = rstd;
    }
    __syncthreads();
    if (sample && GV) {
        float* gv = GV + (size_t)(row0 - MP + i0) * CC;
        for (int e = tid; e < 16 * 384; e += NTHREADS) {
            const int r = e / 384, c4 = (e - r * 384) * 4;
            f32x4 v = *(f32x4*)(gv + (size_t)r * CC + c4); const f32x4 gg = *(const f32x4*)(lvg + c4), bb = *(const f32x4*)(lvb + c4);
            const float mean = sm_mean[i0 + r], rstd = sm_rstd[i0 + r];
            v = (v - mean) * rstd * gg + bb;
            *(f32x4*)(gv + (size_t)r * CC + c4) = v;
        }
    }
    const int h = wave >> 1, cw0 = 192 * wave, l15 = lane & 15, g = lane >> 4;
    const int i = i0 + l15;
    bf16x8 wf[4]; float c1 = 0.f, c2 = 0.f;
    {
        const float* wrow = Ws + ((size_t)h * 128 + i) * 128;
#pragma unroll
        for (int ks = 0; ks < 4; ++ks) {
            u32x4 w = (u32x4){0u, 0u, 0u, 0u};
            if (ks < nks) {
                const int j0 = 32 * ks + 8 * g; const f32x4 w0 = *(const f32x4*)(wrow + j0), w1 = *(const f32x4*)(wrow + j0 + 4);
                const f32x4 r0 = *(const LAS f32x4*)(sm_rstd + j0), r1 = *(const LAS f32x4*)(sm_rstd + j0 + 4), m0 = *(const LAS f32x4*)(sm_mean + j0), m1 = *(const LAS f32x4*)(sm_mean + j0 + 4);
                float wv[8] = {w0[0], w0[1], w0[2], w0[3], w1[0], w1[1], w1[2], w1[3]};
                const float rv[8] = {r0[0], r0[1], r0[2], r0[3], r1[0], r1[1], r1[2], r1[3]}, mv[8] = {m0[0], m0[1], m0[2], m0[3], m1[0], m1[1], m1[2], m1[3]};
#pragma unroll
                for (int e = 0; e < 8; ++e) { const int j = j0 + e; const float wm = (j <= i) ? wv[e] : 0.f; const float wp = wm * rv[e]; c1 += wp * mv[e]; c2 += wm; wv[e] = wp; }
                w.x = cvt_pk_bf16(wv[0], wv[1]); w.y = cvt_pk_bf16(wv[2], wv[3]); w.z = cvt_pk_bf16(wv[4], wv[5]); w.w = cvt_pk_bf16(wv[6], wv[7]);
            }
            wf[ks] = __builtin_bit_cast(bf16x8, w);
        }
        c1 += __shfl_xor(c1, 16); c1 += __shfl_xor(c1, 32); c2 += __shfl_xor(c2, 16); c2 += __shfl_xor(c2, 32);
    }
    f32x4 z[12];
#pragma unroll
    for (int nt = 0; nt < 12; ++nt) z[nt] = (f32x4){0.f, 0.f, 0.f, 0.f};
#pragma unroll
    for (int nt = 0; nt < 12; ++nt) {
        const bf16_t* vp = VT + (size_t)(cw0 + 16 * nt + l15) * MT + row0 + 8 * g;
#pragma unroll
        for (int ks = 0; ks < 4; ++ks) if (ks < nks) {
            const bf16x8 vf = *(const bf16x8*)(vp + 32 * ks);
            z[nt] = __builtin_amdgcn_mfma_f32_16x16x32_bf16(vf, wf[ks], z[nt], 0, 0, 0);
        }
    }
    const float bs = bsp[h * 128 + i];
    const int row = row0 + i;
    float ss = 0.f;
#pragma unroll
    for (int nt = 0; nt < 12; ++nt) {
        const int c = cw0 + 16 * nt + 4 * g; const f32x4 gv = *(const f32x4*)(lvg + c), bv = *(const f32x4*)(lvb + c);
        const u32x2 ug = *(const u32x2*)(P + (size_t)row * PW + P_UG + c);
        const float uu[4] = {bflo(ug.x), bfhi(ug.x), bflo(ug.y), bfhi(ug.y)};
        f32x4 y;
#pragma unroll
        for (int j = 0; j < 4; ++j) { const float zz = gv[j] * (z[nt][j] - c1) + bv[j] * c2 + bs; y[j] = uu[j] * zz; }
        z[nt] = y; ss += (y[0] * y[0] + y[1] * y[1]) + (y[2] * y[2] + y[3] * y[3]);
    }
    ss += __shfl_xor(ss, 16); ss += __shfl_xor(ss, 32);
    if (g == 0) sm_part[wave * 16 + l15] = ss;
    __syncthreads();
    {
        float tot = 0.f;
#pragma unroll
        for (int w = 0; w < 8; ++w) tot += sm_part[w * 16 + l15];
        const float rs = rsqrtf(tot * (1.0f / CC) + EPS);
#pragma unroll
        for (int nt = 0; nt < 12; ++nt) {
            const int c = cw0 + 16 * nt + 4 * g; const f32x4 gb = *(const f32x4*)(g_branch + CC + c);
            const f32x4 y = z[nt] * rs * gb;
            u32x2 w; w.x = cvt_pk_bf16(y[0], y[1]); w.y = cvt_pk_bf16(y[2], y[3]);
            *(u32x2*)(MIX + (size_t)row * DM + CC + c) = w;
        }
    }
    __syncthreads();
}

__device__ __forceinline__ void conv_unit(int a, const bf16_t* P, const bf16_t* GLU, const float* cw, const float* cb,
                                          const float* lg, const float* lb, const float* g_branch, bf16_t* MIX,
                                          LAS float* cbuf, int tid, int wave, int lane) {
    const int row0 = 16 * a;
    const bf16_t* gbase = GLU + (size_t)(glu_row(row0) - 30) * CC;
    const __amdgpu_buffer_rsrc_t rx = __builtin_amdgcn_make_buffer_rsrc((void*)gbase, 0, 46 * CC * 2, 0x00020000);
    const __amdgpu_buffer_rsrc_t rw = __builtin_amdgcn_make_buffer_rsrc((void*)cw, 0, 31 * CC * 4, 0x00020000);
#pragma unroll 1
    for (int it = 0; it < 2; ++it) {
        const int cp = tid + 512 * it;
        if (cp < CC / 2) {
            float w[31][2];
#pragma unroll
            for (int j = 0; j < 31; ++j) { w[j][0] = __builtin_bit_cast(float, __builtin_amdgcn_raw_buffer_load_b32(rw, cp * 8, j * CC * 4, 0)); w[j][1] = __builtin_bit_cast(float, __builtin_amdgcn_raw_buffer_load_b32(rw, cp * 8 + 4, j * CC * 4, 0)); }
            float acc[16][2];
            const float b0 = cb[2 * cp], b1 = cb[2 * cp + 1];
#pragma unroll
            for (int tt = 0; tt < 16; ++tt) { acc[tt][0] = b0; acc[tt][1] = b1; }
#pragma unroll
            for (int r = 0; r < 46; ++r) {
                const unsigned xv = (unsigned)__builtin_amdgcn_raw_buffer_load_b32(rx, cp * 4, r * CC * 2, 0);
                const float x0 = bflo(xv), x1 = bfhi(xv);
#pragma unroll
                for (int tt = 0; tt < 16; ++tt) if (r - tt >= 0 && r - tt <= 30) { acc[tt][0] += w[r - tt][0] * x0; acc[tt][1] += w[r - tt][1] * x1; }
            }
#pragma unroll
            for (int tt = 0; tt < 16; ++tt) { LAS float* d = cbuf + tt * CC + 2 * cp; d[0] = acc[tt][0]; d[1] = acc[tt][1]; }
        }
    }
    __syncthreads();
#pragma unroll
    for (int ti = 0; ti < 2; ++ti) {
        const int tt = 2 * wave + ti, row = row0 + tt;
        f32x4 v[6]; float s1 = 0.f, s2 = 0.f;
#pragma unroll
        for (int i = 0; i < 6; ++i) { v[i] = *(const LAS f32x4*)(cbuf + tt * CC + 4 * lane + 256 * i);
            s1 += (v[i][0] + v[i][1]) + (v[i][2] + v[i][3]); s2 += (v[i][0] * v[i][0] + v[i][1] * v[i][1]) + (v[i][2] * v[i][2] + v[i][3] * v[i][3]); }
        s1 = wave_sum(s1); s2 = wave_sum(s2);
        const float mean = s1 * (1.0f / CC), var = fmaxf(s2 * (1.0f / CC) - mean * mean, 0.f), rstd = rsqrtf(var + EPS);
        float q = 0.f;
#pragma unroll
        for (int i = 0; i < 6; ++i) {
            const int c = 4 * lane + 256 * i;
            const f32x4 gg = *(const f32x4*)(lg + c), bb = *(const f32x4*)(lb + c);
            const u32x2 sg = *(const u32x2*)(P + (size_t)row * PW + P_SGC + c);
            const float sv[4] = {bflo(sg.x), bfhi(sg.x), bflo(sg.y), bfhi(sg.y)};
#pragma unroll
            for (int j = 0; j < 4; ++j) { float y = (v[i][j] - mean) * rstd * gg[j] + bb[j]; y = y * sigmoidf_(y) * sv[j]; v[i][j] = y; q += y * y; }
        }
        q = wave_sum(q);
        const float rs = rsqrtf(q * (1.0f / CC) + EPS);
#pragma unroll
        for (int i = 0; i < 6; ++i) {
            const int c = 4 * lane + 256 * i;
            const f32x4 gb = *(const f32x4*)(g_branch + c);
            const f32x4 y = v[i] * rs * gb;
            u32x2 o; o.x = cvt_pk_bf16(y[0], y[1]); o.y = cvt_pk_bf16(y[2], y[3]);
            *(u32x2*)(MIX + (size_t)row * DM + c) = o;
        }
    }
    __syncthreads();
}

__global__ void __launch_bounds__(NTHREADS, 2) mega_fwd(Args args) {
    extern __shared__ __attribute__((aligned(16))) unsigned char lds_raw[];
    LAS unsigned char* lds = (LAS unsigned char*)lds_raw;
    cg::grid_group grid = cg::this_grid();
    const int tid = threadIdx.x, lane = tid & 63, wave = __builtin_amdgcn_readfirstlane(tid >> 6);
    const int G = gridDim.x, bx = blockIdx.x;
    unsigned char* ws = args.ws;
    float* out = args.out;
    const float* x_prompt = args.in[0]; const float* x_sample = args.in[1]; const float* mem_prompt = args.in[2];
    const float* cache_k = args.in[3]; const float* cache_v = args.in[4]; const float* cache_conv = args.in[5];
    const float* g_pre = args.in[6]; const float* w_in = args.in[7]; const float* conv_w = args.in[8]; const float* conv_b = args.in[9];
    const float* ln_conv_g = args.in[10]; const float* ln_conv_b = args.in[11]; const float* ln_v_g = args.in[12]; const float* ln_v_b = args.in[13];
    const float* w_spatial = args.in[14]; const float* b_spatial = args.in[15]; const float* g_mem = args.in[16]; const float* w_mk = args.in[17]; const float* w_mv = args.in[18];
    const float* g_branch = args.in[19]; const float* w_out = args.in[20]; const float* g_post = args.in[21];
    unsigned* ctl = (unsigned*)(ws + WS_CTL);
    volatile LAS unsigned* bst = (volatile LAS unsigned*)(lds + LDS_BYTES - 16);
    if (tid < 4) bst[tid] = 0u;
    __syncthreads();
    const XcdBarrier xbar = xcd_barrier_post((unsigned*)(ws + CTL_BAR), bst);
    float* vstat = (float*)(ws + CTL_VSTAT); float* oss = (float*)(ws + CTL_OSS);
    bf16_t* WT = (bf16_t*)(ws + WS_WT); bf16_t* WO = (bf16_t*)(ws + WS_WO); bf16_t* H = (bf16_t*)(ws + WS_H); bf16_t* PB = (bf16_t*)(ws + WS_P);
    bf16_t* VT = (bf16_t*)(ws + WS_VT); bf16_t* KB = (bf16_t*)(ws + WS_KB); bf16_t* VTM = (bf16_t*)(ws + WS_VTM); bf16_t* MIX = (bf16_t*)(ws + WS_MIX); bf16_t* OB = (bf16_t*)(ws + WS_OUT); bf16_t* GLU = (bf16_t*)(ws + WS_GLU); bf16_t* QF = (bf16_t*)(ws + WS_QF); bf16_t* OF = (bf16_t*)(ws + WS_OF);

#ifndef REP_P0
#define REP_P0 1
#endif
#ifndef REP_P2
#define REP_P2 1
#endif
#ifndef REP_P4
#define REP_P4 1
#endif
    for (int rep0 = 0; rep0 < REP_P0; ++rep0) {
        const int gw = bx * 8 + wave, NGW = G * 8;
        LAS float* scr = (LAS float*)(lds + wave * 16640);
        constexpr int I_IN = 64 * 176, I_MK = 64 * 16, I_CV = 16 * 64, NITEMS = I_IN + 2 * I_MK + I_CV;
        for (int it = gw; it < NITEMS; it += NGW) {
            int r = it;
            if (r < I_IN) { const int kb = r / 176, nb = r - kb * 176; transpose_item64(w_in, NIN, WT, DM, 64 * kb, 64 * nb, win_dest_row(64 * nb) - 64 * nb, scr, lane); continue; } r -= I_IN;
            if (r < I_MK) { const int kb = r >> 4, nb = r & 15; transpose_item64(w_mk, CX, WT, DM, 64 * kb, 64 * nb, NIN, scr, lane); continue; } r -= I_MK;
            if (r < I_MK) { const int kb = r >> 4, nb = r & 15; transpose_item64(w_mv, CX, WT, DM, 64 * kb, 64 * nb, NIN + CX, scr, lane); continue; } r -= I_MK;
            { const int b = r >> 6, q = r & 63, kb = q >> 4, nb = q & 15; transpose_item64(cache_v + (size_t)b * 256 * 1024, 1024, VTM + (size_t)(2 + b) * 1024 * 256, 256, 64 * kb, 64 * nb, 0, scr, lane); }
        }
        for (int m = gw; m < MT + MEMR; m += NGW) {
            const float* src; const float* gg;
            if (m < MP) { src = x_prompt + (size_t)m * DM; gg = g_pre; } else if (m < MT) { src = x_sample + (size_t)(m - MP) * DM; gg = g_pre; } else { src = mem_prompt + (size_t)(m - MT) * DM; gg = g_mem; }
            rms_row_bf16(src, gg, H + (size_t)m * DM, lane);
        }
        for (int i = gw * 64 + lane; i < 16 * 256 * 1024 / 4; i += NGW * 64) {
            const f32x4 v = __builtin_nontemporal_load((const f32x4*)cache_k + i);
            u32x2 o; o.x = cvt_pk_bf16(v[0], v[1]); o.y = cvt_pk_bf16(v[2], v[3]);
            ((u32x2*)(KB + (size_t)2 * 256 * 1024))[i] = o;
        }
        for (int i = gw * 64 + lane; i < 18 * 30 * CC / 4; i += NGW * 64) {
            const int hr = i / (CC / 4), c4 = i - hr * (CC / 4), b = hr / 30, r = hr - b * 30;
            u32x2 o = (u32x2){0u, 0u};
            if (b >= 2) { const f32x4 v = ((const f32x4*)cache_conv)[i - 2 * 30 * CC / 4]; o.x = cvt_pk_bf16(v[0], v[1]); o.y = cvt_pk_bf16(v[2], v[3]); }
            const int grow = (b < 2 ? b * 4126 : 8252 + (b - 2) * 94) + r;
            ((u32x2*)(GLU + (size_t)grow * CC))[c4] = o;
        }
    }
    if (gridDim.y == 0x7fffu) grid.sync();
    xcd_barrier(xbar);

    {
#ifndef NO_G1
        { pg8::Gemm g{H, WT, DM}; Sched1 S{bx}; EpiMix<Epi1> E{Epi1{PB, GLU, VT, vstat, out, KB, VTM}, EpiSlab{QF, CX, 0, 36, SLAB}};
          pg8::gemm_phase<EpiMix<Epi1>, Sched1>(lds, g, S, E); }
#endif
    }
    xcd_barrier(xbar);

    for (int rep2 = 0; rep2 < REP_P2; ++rep2) {
        LAS float* cbuf = (LAS float*)lds;
        LAS float* sm = (LAS float*)(lds + 135168);
        LAS int* sm_next = (LAS int*)(lds + 135168 + 4096);
        constexpr int NA = 80, NC = 576, NB = 576, NW = 512, NU = NA + NC + NB + NW;
        for (;;) {
            if (tid == 0) *sm_next = (int)atomicAdd(ctl + 64 * rep2, 1u);
            __syncthreads();
            const int u = __builtin_amdgcn_readfirstlane(*sm_next);
            __syncthreads();
            if (u >= NU) break;
            int tidv = tid, wv = wave;
            asm volatile("" : "+v"(tidv), "+s"(wv));
            tidv &= 511; wv &= 7;
            const int lanev = tidv & 63;
#ifndef P2_MASK
#define P2_MASK 7
#endif
            const int pmask = rep2 == 0 ? 7 : P2_MASK;
            if (u >= NA + NC + NB) {
                const int it = 8 * (u - NA - NC - NB) + wv;
                transpose_item64(w_out, DM, WO, DM, 64 * (it >> 6), 64 * (it & 63), 0, (LAS float*)(lds + wv * 16640), lanev);
                __syncthreads();
            } else if (u < NA) {
                if (pmask & 1) {
#ifndef NO_ATTN
                attn_unit(u, PB, QF, KB, VTM, g_branch, MIX, lds, tidv, wv, lanev);
#endif
                }
            } else if (u >= NA + NB) {
                if (pmask & 2) {
#ifndef NO_CONV
                conv_unit(u - NA - NB, PB, GLU, conv_w, conv_b, ln_conv_g, ln_conv_b, g_branch, MIX, cbuf, tidv, wv, lanev);
#endif
                }
            } else {
                if (pmask & 4) {
#ifndef NO_GMLP
                gmlp_unit(u - NA, PB, VT, vstat, w_spatial, b_spatial, ln_v_g, ln_v_b, g_branch, rep2 == 0 ? out + O_GV : nullptr, MIX, sm, tidv, wv, lanev);
#endif
                }
            }
        }
    }
    xcd_barrier(xbar);

    {
#ifndef NO_G2
        { pg8::Gemm g{MIX, WO, DM}; Sched2 S{bx}; EpiMix<Epi2F> E{Epi2F{x_prompt, g_post, out + O_Y, oss, (unsigned*)(ws + CTL_PCNT)}, EpiSlab{OF, DM, 32, 0, SLAB}};
          pg8::gemm_phase<EpiMix<Epi2F>, Sched2>(lds, g, S, E); }
#endif
    }
    xcd_barrier(xbar);

    for (int rep4 = 0; rep4 < REP_P4; ++rep4) {
        const int lane = opq(tid) & 63;
        const int gw = bx * 8 + wave, NGW = G * 8;
        for (int m = MP + gw; m < MT; m += NGW) {
            float* yr = out + O_Y + (size_t)m * DM;
            if (m < MP) {
                const float* xr = x_prompt + (size_t)m * DM; const bf16_t* orow = OB + (size_t)m * DM;
                u32x4 ov[8]; f32x4 xv[16]; float q = 0.f;
#pragma unroll
                for (int j = 0; j < 8; ++j) ov[j] = *(const u32x4*)(orow + (lane + 64 * j) * 8);
#pragma unroll
                for (int j = 0; j < 8; ++j) { xv[2 * j] = *(const f32x4*)(xr + (lane + 64 * j) * 8); xv[2 * j + 1] = *(const f32x4*)(xr + (lane + 64 * j) * 8 + 4); }
#pragma unroll
                for (int j = 0; j < 8; ++j) {
                    const float a0 = bflo(ov[j].x), a1 = bfhi(ov[j].x), a2 = bflo(ov[j].y), a3 = bfhi(ov[j].y), a4 = bflo(ov[j].z), a5 = bfhi(ov[j].z), a6 = bflo(ov[j].w), a7 = bfhi(ov[j].w);
                    q += (a0 * a0 + a1 * a1) + (a2 * a2 + a3 * a3) + (a4 * a4 + a5 * a5) + (a6 * a6 + a7 * a7); }
                q = wave_sum(q);
                const float rs = rsqrtf(q * (1.0f / DM) + EPS);
#pragma unroll
                for (int j = 0; j < 8; ++j) {
                    const int c = (lane + 64 * j) * 8;
                    const f32x4 x0 = xv[2 * j], x1 = xv[2 * j + 1], g0 = *(const f32x4*)(g_post + c), g1 = *(const f32x4*)(g_post + c + 4);
                    f32x4 y0, y1;
                    y0[0] = x0[0] + bflo(ov[j].x) * rs * g0[0]; y0[1] = x0[1] + bfhi(ov[j].x) * rs * g0[1]; y0[2] = x0[2] + bflo(ov[j].y) * rs * g0[2]; y0[3] = x0[3] + bfhi(ov[j].y) * rs * g0[3];
                    y1[0] = x1[0] + bflo(ov[j].z) * rs * g1[0]; y1[1] = x1[1] + bfhi(ov[j].z) * rs * g1[1]; y1[2] = x1[2] + bflo(ov[j].w) * rs * g1[2]; y1[3] = x1[3] + bfhi(ov[j].w) * rs * g1[3];
                    *(f32x4*)(yr + c) = y0; *(f32x4*)(yr + c + 4) = y1;
                }
            } else {
                const float* xr = x_sample + (size_t)(m - MP) * DM; const bf16_t* orow = OF + (size_t)(m - MP) * DM;
                f32x4 ov[16]; float q = 0.f;
#pragma unroll
                for (int j = 0; j < 16; ++j) { const bf16_t* op = orow + (lane + 64 * j) * 4;
                    const u32x2 p0 = *(const u32x2*)op, p1 = *(const u32x2*)(op + SLAB), p2 = *(const u32x2*)(op + 2 * SLAB), p3 = *(const u32x2*)(op + 3 * SLAB);
                    ov[j][0] = (bflo(p0.x) + bflo(p1.x)) + (bflo(p2.x) + bflo(p3.x)); ov[j][1] = (bfhi(p0.x) + bfhi(p1.x)) + (bfhi(p2.x) + bfhi(p3.x));
                    ov[j][2] = (bflo(p0.y) + bflo(p1.y)) + (bflo(p2.y) + bflo(p3.y)); ov[j][3] = (bfhi(p0.y) + bfhi(p1.y)) + (bfhi(p2.y) + bfhi(p3.y));
                    q += (ov[j][0] * ov[j][0] + ov[j][1] * ov[j][1]) + (ov[j][2] * ov[j][2] + ov[j][3] * ov[j][3]); }
                q = wave_sum(q);
                const float rs = rsqrtf(q * (1.0f / DM) + EPS);
#pragma unroll
                for (int j = 0; j < 16; ++j) {
                    const int c = (lane + 64 * j) * 4;
                    const f32x4 x0 = __builtin_nontemporal_load((const f32x4*)(xr + c)), g0 = *(const f32x4*)(g_post + c);
                    __builtin_nontemporal_store(x0 + ov[j] * rs * g0, (f32x4*)(yr + c));
                }
            }
        }
    }
}

extern "C" void kernel_launch(void* const* d_in, const int* in_sizes, int n_in, void* d_out, int out_size, void* d_ws, size_t ws_size, hipStream_t stream) {
    static int grid = 0;
    if (grid == 0) {
        if (n_in != 22 || ws_size < WS_END) { fprintf(stderr, "kernel_launch: unexpected inputs (n_in %d, ws %zu)\n", n_in, ws_size); grid = -1; return; }
        int dev = 0, cus = 0, per_cu = 0;
        (void)hipGetDevice(&dev);
        (void)hipDeviceGetAttribute(&cus, hipDeviceAttributeMultiprocessorCount, dev);
        if (hipFuncSetAttribute((const void*)mega_fwd, hipFuncAttributeMaxDynamicSharedMemorySize, LDS_BYTES) != hipSuccess) { fprintf(stderr, "kernel_launch: hipFuncSetAttribute failed\n"); grid = -1; return; }
        if (hipOccupancyMaxActiveBlocksPerMultiprocessor(&per_cu, (const void*)mega_fwd, NTHREADS, LDS_BYTES) != hipSuccess || per_cu < 1) { fprintf(stderr, "kernel_launch: occupancy query says %d\n", per_cu); per_cu = 1; }
        (void)hipGetLastError();
        grid = 256;
        if (cus != 256) fprintf(stderr, "kernel_launch: built for a 256-CU device, found %d CUs\n", cus);
    }
    if (grid < 0) return;
    (void)hipMemsetAsync((char*)d_ws + WS_CTL, 0, CTL_BYTES, stream);
    Args a{};
    for (int i = 0; i < 22; ++i) a.in[i] = (const float*)d_in[i];
    a.out = (float*)d_out; a.ws = (unsigned char*)d_ws;
    void* kargs[] = {&a};
    hipError_t e = hipLaunchCooperativeKernel((const void*)mega_fwd, dim3(grid), dim3(NTHREADS), kargs, LDS_BYTES, stream);
    if (e != hipSuccess) fprintf(stderr, "kernel_launch: cooperative launch failed: %s (grid %d)\n", hipGetErrorString(e), grid);
}
```

```cpp
#include <hip/hip_runtime.h>
#include <hip/hip_cooperative_groups.h>
#include <cstdio>
#include <cstdint>
namespace cg = cooperative_groups;

#define LAS __attribute__((address_space(3)))
typedef unsigned short bf16_t;
typedef short bf16x8 __attribute__((ext_vector_type(8)));
typedef short s16x4 __attribute__((ext_vector_type(4)));
typedef float f32x4 __attribute__((ext_vector_type(4)));
typedef unsigned u32x4 __attribute__((ext_vector_type(4)));
typedef unsigned u32x2 __attribute__((ext_vector_type(2)));

constexpr int DM = 4096;
constexpr int MP = 8192, MS = 1024, MT = MP + MS;
constexpr int NIN = 11264;
constexpr int CC = 1536;
constexpr int CX = 1024;
constexpr int MEMR = 512;
constexpr float EPS = 1e-6f;
constexpr int PW = 5120;
constexpr int P_UG = 0, P_SGC = 1536, P_Q = 3072, P_SGX = 4096;
constexpr int GROWS = MT + 18 * 30;
__device__ __forceinline__ int glu_row(int row) { return row < MP ? row + 30 * ((row >> 12) + 1) : row + 30 * (((row - MP) >> 6) + 3); }
constexpr float QSCALE = 0.0625f * 1.4426950408889634f;

constexpr size_t O_Y = 0, O_MK = (size_t)MT * DM, O_MV = O_MK + 524288, O_CP = O_MV + 524288, O_CS = O_CP + 92160, O_GV = O_CS + 737280;

constexpr size_t MiB = 1u << 20;
constexpr size_t WS_CTL = 0, CTL_BYTES = 262144;
constexpr size_t CTL_BAR = 131072;
constexpr size_t CTL_PCNT = 196608;
constexpr size_t CTL_VSTAT = 4096, CTL_OSS = CTL_VSTAT + (size_t)MT * 8;
static_assert(CTL_OSS + (size_t)MT * 4 <= CTL_BYTES, "ctl");
constexpr size_t WS_WT = 2 * MiB;
constexpr size_t WS_WO = 106 * MiB;
constexpr size_t WS_H = 138 * MiB;
constexpr size_t WS_P = 214 * MiB;
constexpr size_t WS_VT = 332 * MiB;
constexpr size_t WS_KB = 360 * MiB;
constexpr size_t WS_VTM = 370 * MiB;
constexpr size_t WS_MIX = 380 * MiB;
constexpr size_t WS_OUT = 452 * MiB;
constexpr size_t WS_GLU = 524 * MiB;
constexpr size_t WS_QF = 556 * MiB;
constexpr size_t WS_OF = 620 * MiB;
constexpr size_t WS_END = 684 * MiB;
constexpr size_t SLAB = (size_t)4096 * 1024;
static_assert(WS_GLU + (size_t)GROWS * CC * 2 <= WS_END, "glu");
static_assert(WS_WT + (size_t)13312 * 4096 * 2 <= WS_WO && WS_WO + (size_t)4096 * 4096 * 2 <= WS_H && WS_H + (size_t)9728 * 4096 * 2 <= WS_P &&
              WS_P + (size_t)MT * PW * 2 <= WS_VT && WS_VT + (size_t)CC * MT * 2 <= WS_KB && WS_KB + (size_t)18 * 256 * 1024 * 2 <= WS_VTM &&
              WS_VTM + (size_t)18 * 1024 * 256 * 2 <= WS_MIX && WS_MIX + (size_t)MT * DM * 2 <= WS_OUT && WS_OUT + (size_t)MT * DM * 2 <= WS_END, "ws map");

constexpr int LDS_BYTES = 143360;
constexpr int NTHREADS = 512;

__device__ __forceinline__ unsigned cvt_pk_bf16(float lo, float hi) { unsigned r; asm volatile("v_cvt_pk_bf16_f32 %0, %1, %2" : "=v"(r) : "v"(lo), "v"(hi)); return r; }
__device__ __forceinline__ bf16_t f2bf(float f) { return (bf16_t)(cvt_pk_bf16(f, 0.f) & 0xffffu); }
__device__ __forceinline__ float bf2f(bf16_t u) { return __uint_as_float(((unsigned)u) << 16); }
__device__ __forceinline__ float bflo(unsigned u) { return __uint_as_float(u << 16); }
__device__ __forceinline__ float bfhi(unsigned u) { return __uint_as_float(u & 0xffff0000u); }
__device__ __forceinline__ float sigmoidf_(float x) { return __builtin_amdgcn_rcpf(1.0f + __builtin_amdgcn_exp2f(-1.4426950408889634f * x)); }
__device__ __forceinline__ float wave_sum(float v) {
#pragma unroll
    for (int o = 1; o < 64; o <<= 1) v += __shfl_xor(v, o);
    return v;
}
#define LDS_WAIT() asm volatile("s_waitcnt lgkmcnt(0)" ::: "memory")
__device__ __forceinline__ int opq(int x) { asm volatile("" : "+v"(x)); return x; }

namespace pg8 {
constexpr int BM = 256, BK = 64, HALF = 128, HTB = HALF * BK * 2, STAGE_BYTES = 8 * HTB;
__device__ __forceinline__ int lds_byte(int r, int c) { const int st = (r >> 4) * 2 + (c >> 5), rr = r & 15, cc = c & 31, ob = rr * 64 + cc * 2; return st * 1024 + (ob ^ (((ob >> 9) & 1) << 5)); }
__device__ __forceinline__ void stage_rc(int b, int& R, int& C) { const int st = b / 1024, sb = b % 1024, swz = sb ^ (((sb >> 9) & 1) << 5); R = (st >> 1) * 16 + swz / 64; C = (st & 1) * 32 + (swz % 64) / 2; }
__device__ __forceinline__ int perm32(int rho) { const int n = rho >> 4, i = rho & 15; return 8 * (i >> 2) + 4 * n + (i & 3); }
struct Unit { int pm, pn, koff, kt; };
struct Gemm { const bf16_t* A; const bf16_t* Bt; int ld; };

template <class Epi, class Sched>
__device__ __forceinline__ void gemm_phase(LAS unsigned char* lds, const Gemm g, const Sched& S, const Epi& E) {
    const int tid = opq((int)threadIdx.x) & 511, wid = __builtin_amdgcn_readfirstlane(tid >> 6), lane = tid & 63, wr = wid >> 2, wc = wid & 3, fr = lane & 15, fq = lane >> 4;
    const int K = g.ld;
    unsigned voffA[2], voffB[2];
#pragma unroll
    for (int i = 0; i < 2; ++i) { int R, C; stage_rc(tid * 16 + i * 8192, R, C); const int Rb = (R & ~31) + perm32(R & 31);
        voffA[i] = (unsigned)(R * K + C) * 2u; voffB[i] = (unsigned)(Rb * K + C) * 2u; }
    const size_t kstep = (size_t)(BK * 2);
    const size_t hstep = (size_t)HALF * K * 2;
    const size_t tstep = 2 * hstep;
    const unsigned ldsw = (unsigned)wid * 1024u;
    const int aoff = lds_byte(wr * 64 + fr, fq * 8), boff = lds_byte(wc * 32 + fr, fq * 8);
#define PG8_SA(b, h) (((b) * 2 + (h)) * HTB)
#define PG8_SB(b, h) ((4 + (b) * 2 + (h)) * HTB)
#define PG8_STAGE(bufoff, gbase, voff) do { _Pragma("unroll") for (int _i = 0; _i < 2; ++_i) \
        __builtin_amdgcn_global_load_lds((const unsigned*)((const char*)(gbase) + (voff)[_i]), (LAS unsigned*)(lds + (bufoff) + ldsw + _i * 8192), 16, 0, 0); } while (0)
#define PG8_LDA(dst, b, h) do { _Pragma("unroll") for (int m = 0; m < 4; ++m) _Pragma("unroll") for (int k = 0; k < 2; ++k) dst[m][k] = *(const LAS bf16x8*)(lds + PG8_SA(b, h) + aoff + m * 2048 + k * 1024); } while (0)
#define PG8_LDB(dst, b, h) do { _Pragma("unroll") for (int n = 0; n < 2; ++n) _Pragma("unroll") for (int k = 0; k < 2; ++k) dst[n][k] = *(const LAS bf16x8*)(lds + PG8_SB(b, h) + boff + n * 2048 + k * 1024); } while (0)
#define PG8_MMA(ai, bj, At, Bt) do { __builtin_amdgcn_s_setprio(1); _Pragma("unroll") for (int m = 0; m < 4; ++m) _Pragma("unroll") for (int n = 0; n < 2; ++n) _Pragma("unroll") for (int k = 0; k < 2; ++k) \
        acc[ai][bj][m][n] = __builtin_amdgcn_mfma_f32_16x16x32_bf16(Bt[n][k], At[m][k], acc[ai][bj][m][n], 0, 0, 0); __builtin_amdgcn_s_setprio(0); } while (0)
#define PG8_WAIT_V(n) asm volatile("s_waitcnt vmcnt(" #n ")" ::: "memory")
#define PG8_WAIT_L(n) asm volatile("s_waitcnt lgkmcnt(" #n ")" ::: "memory")
#define PG8_BAR __builtin_amdgcn_s_barrier()
#define PG8_SCHED __builtin_amdgcn_sched_barrier(0)
    Unit cur, nxt; int ui = 0;
    if (!S.next(0, cur)) return;
    f32x4 acc[2][2][4][2];
#pragma unroll
    for (int a = 0; a < 2; ++a)
#pragma unroll
        for (int b = 0; b < 2; ++b)
#pragma unroll
            for (int m = 0; m < 4; ++m)
#pragma unroll
                for (int n = 0; n < 2; ++n) acc[a][b][m][n] = (f32x4){0.f, 0.f, 0.f, 0.f};
    bf16x8 At[4][2], B0[2][2], B1[2][2];
    const char* cA = (const char*)g.A + (size_t)cur.pm * tstep + (size_t)cur.koff * 2; const char* cB = (const char*)g.Bt + (size_t)cur.pn * tstep + (size_t)cur.koff * 2;
    PG8_STAGE(PG8_SB(0, 0), cB, voffB); PG8_STAGE(PG8_SB(0, 1), cB + hstep, voffB); PG8_STAGE(PG8_SA(0, 0), cA, voffA); PG8_STAGE(PG8_SA(0, 1), cA + hstep, voffA);
    if (wr == 1) PG8_BAR;
    PG8_WAIT_V(2); PG8_BAR;
    PG8_STAGE(PG8_SB(1, 0), cB + kstep, voffB); PG8_STAGE(PG8_SA(1, 0), cA + kstep, voffA); PG8_STAGE(PG8_SB(1, 1), cB + hstep + kstep, voffB);
    PG8_WAIT_V(6); PG8_BAR;
    for (;;) {
        const bool has_next = S.next(ui + 1, nxt);
        const char* nA = has_next ? (const char*)g.A + (size_t)nxt.pm * tstep + (size_t)nxt.koff * 2 : cA; const char* nB = has_next ? (const char*)g.Bt + (size_t)nxt.pn * tstep + (size_t)nxt.koff * 2 : cB;
        const int nt = cur.kt;
        for (int t = 0; t < nt; t += 2) {
            const bool last = (t == nt - 2);
            const char* a1 = cA + (size_t)(t + 1) * kstep;
            const char* a2 = last ? nA : cA + (size_t)(t + 2) * kstep; const char* b2 = last ? nB : cB + (size_t)(t + 2) * kstep;
            const char* a3 = a2 + kstep; const char* b3 = b2 + kstep;
            PG8_LDB(B0, 0, 0); PG8_LDB(B1, 0, 1); PG8_SCHED; PG8_LDA(At, 0, 0); PG8_STAGE(PG8_SA(1, 1), a1 + hstep, voffA);
            PG8_WAIT_V(8); PG8_WAIT_L(0); PG8_BAR; PG8_MMA(0, 0, At, B0); PG8_MMA(0, 1, At, B1); PG8_BAR; PG8_SCHED;
            PG8_LDA(At, 0, 1); PG8_STAGE(PG8_SB(0, 0), b2, voffB); PG8_STAGE(PG8_SB(0, 1), b2 + hstep, voffB); PG8_STAGE(PG8_SA(0, 0), a2, voffA);
            PG8_WAIT_V(8); PG8_WAIT_L(0); PG8_BAR; PG8_MMA(1, 0, At, B0); PG8_MMA(1, 1, At, B1); PG8_BAR; PG8_SCHED;
            PG8_LDB(B0, 1, 0); PG8_LDB(B1, 1, 1); PG8_SCHED; PG8_LDA(At, 1, 0); PG8_STAGE(PG8_SA(0, 1), a2 + hstep, voffA);
            PG8_WAIT_V(8); PG8_WAIT_L(0); PG8_BAR; PG8_MMA(0, 0, At, B0); PG8_MMA(0, 1, At, B1); PG8_BAR; PG8_SCHED;
            PG8_LDA(At, 1, 1); PG8_STAGE(PG8_SB(1, 0), b3, voffB); PG8_STAGE(PG8_SB(1, 1), b3 + hstep, voffB); PG8_STAGE(PG8_SA(1, 0), a3, voffA);
            PG8_WAIT_V(8); PG8_WAIT_L(0); PG8_BAR; PG8_MMA(1, 0, At, B0); PG8_MMA(1, 1, At, B1); PG8_BAR; PG8_SCHED;
        }
        if (wr == 0) PG8_BAR;
        E(acc, cur, wr, wc, fr, fq);
        if (!has_next) break;
#pragma unroll
        for (int a = 0; a < 2; ++a)
#pragma unroll
            for (int b = 0; b < 2; ++b)
#pragma unroll
                for (int m = 0; m < 4; ++m)
#pragma unroll
                    for (int n = 0; n < 2; ++n) acc[a][b][m][n] = (f32x4){0.f, 0.f, 0.f, 0.f};
        cur = nxt; cA = nA; cB = nB; ++ui;
        if (wr == 1) PG8_BAR;
    }
    PG8_WAIT_V(0);
    PG8_BAR;
#undef PG8_SA
#undef PG8_SB
#undef PG8_STAGE
#undef PG8_LDA
#undef PG8_LDB
#undef PG8_MMA
#undef PG8_WAIT_V
#undef PG8_WAIT_L
#undef PG8_BAR
#undef PG8_SCHED
}
}

__device__ __forceinline__ void static_unit(int L, int nM, int nN, pg8::Unit& u) {
    const int nwg = nM * nN;
    int wgid = L; { const int q = nwg / 8, r = nwg % 8, xcd = wgid % 8, off = wgid / 8; wgid = (xcd < r ? xcd * (q + 1) : r * (q + 1) + (xcd - r) * q) + off; }
    const int nig = 8 * nN, gid = wgid / nig, fm = gid * 8, gsz = (nM - fm) < 8 ? (nM - fm) : 8;
    u.pm = fm + ((wgid % nig) % gsz); u.pn = (wgid % nig) / gsz; u.koff = 0; u.kt = 64;
}
__device__ __forceinline__ void g1_full_unit(int L, pg8::Unit& u) {
    pg8::Unit t; static_unit(L < 1440 ? L : 0, 36, 40, t); if (t.pn >= 36) t.pn += 4;
    const int r = L - 1440; const bool tail = L >= 1440, isq = r < 80;
    u.pm = tail ? (isq ? 16 + (r >> 2) : 36 + ((r - 80) >> 3)) : t.pm; u.pn = tail ? (isq ? 36 + (r & 3) : 44 + ((r - 80) & 7)) : t.pn; u.koff = 0; u.kt = 64;
}
struct Sched1 {
    int c;
    __device__ __forceinline__ bool next(int i, pg8::Unit& u) const {
        if (i >= 7) return false;
        const bool qfirst = (c & 4) != 0; const bool isq = (i == (qfirst ? 0 : 6));
        pg8::Unit f; g1_full_unit((qfirst ? (i > 0 ? i - 1 : 0) : (i < 6 ? i : 0)) * 256 + c, f);
        const int xcd = c & 7, j = c >> 3;
        u.pm = isq ? 2 * xcd + (j >> 4) : f.pm; u.pn = isq ? 36 + ((j & 15) >> 2) : f.pn; u.koff = isq ? 1024 * (j & 3) : 0; u.kt = isq ? 16 : 64;
        return true;
    }
};
struct Sched2 {
    int c;
    __device__ __forceinline__ bool next(int i, pg8::Unit& u) const {
        if (i >= 3) return false;
        const bool qfirst = (c & 4) != 0; const bool isq = (i == (qfirst ? 0 : 2));
        const int xcd = c & 7, j = c >> 3, r = qfirst ? i - 1 : i;
        u.pm = isq ? 32 + (xcd >> 1) : 16 * r + 2 * xcd + (j >> 4); u.pn = j & 15; u.koff = isq ? 1024 * (2 * (xcd & 1) + (j >> 4)) : 0; u.kt = isq ? 16 : 64;
        return true;
    }
};

struct Epi1 {
    bf16_t* P; bf16_t* GLU; bf16_t* VT; float* vstat; float* out; bf16_t* KB; bf16_t* VTM;
    __device__ __forceinline__ void operator()(const f32x4 (&acc)[2][2][4][2], const pg8::Unit& u, int wr, int wc, int fr, int fq) const {
        asm volatile("" : "+v"(fr), "+v"(fq));
        const int pm = u.pm, pn = u.pn;
        const int rb = pm * 256 + wr * 64 + fr;
        const int cl = wc * 32 + 8 * fq;
        if (pn < 24) {
            const bool isglu = pn < 12; const int t = isglu ? pn : pn - 12;
            bf16_t* base = (isglu ? GLU : P + P_UG) + t * 128 + cl;
#pragma unroll
            for (int ai = 0; ai < 2; ++ai)
#pragma unroll
                for (int m = 0; m < 4; ++m) {
                    const int row = rb + ai * 128 + m * 16;
                    f32x4 r0, r1; const f32x4 x0 = acc[ai][0][m][0], x1 = acc[ai][0][m][1], g0 = acc[ai][1][m][0], g1 = acc[ai][1][m][1];
#pragma unroll
                    for (int j = 0; j < 4; ++j) {
                        float s0 = sigmoidf_(g0[j]), s1 = sigmoidf_(g1[j]);
                        if (!isglu) { s0 *= g0[j]; s1 *= g1[j]; }
                        r0[j] = x0[j] * s0; r1[j] = x1[j] * s1;
                    }
                    u32x4 w; w.x = cvt_pk_bf16(r0[0], r0[1]); w.y = cvt_pk_bf16(r0[2], r0[3]); w.z = cvt_pk_bf16(r1[0], r1[1]); w.w = cvt_pk_bf16(r1[2], r1[3]);
                    *(u32x4*)(base + (isglu ? (size_t)glu_row(row) * CC : (size_t)row * PW)) = w;
                    if (isglu) {
                        float* dst = nullptr;
                        if (row < MP) { const int tt = row & 4095; if (tt >= 4066) dst = out + O_CP + ((size_t)(row >> 12) * 30 + (tt - 4066)) * CC; }
                        else { const int rr = row - MP, tt = rr & 63; if (tt >= 34) dst = out + O_CS + ((size_t)(rr >> 6) * 30 + (tt - 34)) * CC; }
                        if (dst) { dst += t * 128 + cl; *(f32x4*)dst = r0; *(f32x4*)(dst + 4) = r1; }
                    }
                }
        } else if (pn < 30 || (pn >= 36 && pn < 44)) {
            int cb; bool act = true;
            if (pn < 30) cb = P_SGC + (pn - 24) * 256; else if (pn < 40) { cb = P_Q + (pn - 36) * 256; act = false; } else cb = P_SGX + (pn - 40) * 256;
            bf16_t* base = P + cb + cl;
#pragma unroll
            for (int ai = 0; ai < 2; ++ai)
#pragma unroll
                for (int m = 0; m < 4; ++m) {
                    const int row = rb + ai * 128 + m * 16;
#pragma unroll
                    for (int bj = 0; bj < 2; ++bj) {
                        f32x4 v0 = acc[ai][bj][m][0], v1 = acc[ai][bj][m][1];
#pragma unroll
                        for (int j = 0; j < 4; ++j) {
                            if (act) { v0[j] *= sigmoidf_(v0[j]); v1[j] *= sigmoidf_(v1[j]); } else { v0[j] *= QSCALE; v1[j] *= QSCALE; }
                        }
                        u32x4 w; w.x = cvt_pk_bf16(v0[0], v0[1]); w.y = cvt_pk_bf16(v0[2], v0[3]); w.z = cvt_pk_bf16(v1[0], v1[1]); w.w = cvt_pk_bf16(v1[2], v1[3]);
                        *(u32x4*)(base + (size_t)row * PW + bj * 128) = w;
                    }
                }
        } else if (pn < 36) {
            const int c0 = (pn - 30) * 256 + cl;
#pragma unroll
            for (int ai = 0; ai < 2; ++ai)
#pragma unroll
                for (int m = 0; m < 4; ++m) {
                    const int row = rb + ai * 128 + m * 16;
                    float s = 0.f, q = 0.f;
#pragma unroll
                    for (int bj = 0; bj < 2; ++bj)
#pragma unroll
                        for (int n = 0; n < 2; ++n) {
                            const f32x4 v = acc[ai][bj][m][n];
#pragma unroll
                            for (int j = 0; j < 4; ++j) { s += v[j]; q += v[j] * v[j]; VT[(size_t)(c0 + bj * 128 + 4 * n + j) * MT + row] = f2bf(v[j]); }
                        }
                    s += __shfl_xor(s, 16); s += __shfl_xor(s, 32); q += __shfl_xor(q, 16); q += __shfl_xor(q, 32);
                    if (fq == 0) { atomicAdd(vstat + 2 * row, s); atomicAdd(vstat + 2 * row + 1, q); }
                    if (row >= MP) {
                        float* dst = out + O_GV + (size_t)(row - MP) * CC + c0;
#pragma unroll
                        for (int bj = 0; bj < 2; ++bj) { *(f32x4*)(dst + bj * 128) = acc[ai][bj][m][0]; *(f32x4*)(dst + bj * 128 + 4) = acc[ai][bj][m][1]; }
                    }
                }
        } else {
            const int b = pm - 36, hh = (pn - 44) & 3; const bool isv = pn >= 48;
            float* fo = out + (isv ? O_MV : O_MK);
#pragma unroll
            for (int ai = 0; ai < 2; ++ai)
#pragma unroll
                for (int m = 0; m < 4; ++m) {
                    const int mr = wr * 64 + fr + ai * 128 + m * 16;
                    const size_t rowg = (size_t)b * 256 + mr;
#pragma unroll
                    for (int bj = 0; bj < 2; ++bj) {
                        const f32x4 v0 = acc[ai][bj][m][0], v1 = acc[ai][bj][m][1];
                        const int d0 = bj * 128 + cl;
                        float* dst = fo + rowg * 1024 + hh * 256 + d0; *(f32x4*)dst = v0; *(f32x4*)(dst + 4) = v1;
                        if (!isv) {
                            u32x4 w; w.x = cvt_pk_bf16(v0[0], v0[1]); w.y = cvt_pk_bf16(v0[2], v0[3]); w.z = cvt_pk_bf16(v1[0], v1[1]); w.w = cvt_pk_bf16(v1[2], v1[3]);
                            *(u32x4*)(KB + rowg * 1024 + hh * 256 + d0) = w;
                        } else {
#pragma unroll
                            for (int j = 0; j < 4; ++j) { VTM[((size_t)(b * 4 + hh) * 256 + d0 + j) * 256 + mr] = f2bf(v0[j]); VTM[((size_t)(b * 4 + hh) * 256 + d0 + 4 + j) * 256 + mr] = f2bf(v1[j]); }
                        }
                    }
                }
        }
    }
};

struct Epi2F {
    const float* xp; const float* gpost; float* y; float* oss; unsigned* cnt;
    __device__ __forceinline__ void operator()(const f32x4 (&acc)[2][2][4][2], const pg8::Unit& u, int wr, int wc, int fr, int fq) const {
        asm volatile("" : "+v"(fr), "+v"(fq));
        const int rb = u.pm * 256 + wr * 64 + fr;
#pragma unroll
        for (int ai = 0; ai < 2; ++ai)
#pragma unroll
            for (int m = 0; m < 4; ++m) {
                float q = 0.f;
#pragma unroll
                for (int bj = 0; bj < 2; ++bj) {
                    const f32x4 v0 = acc[ai][bj][m][0], v1 = acc[ai][bj][m][1];
                    q += (v0[0] * v0[0] + v0[1] * v0[1]) + (v0[2] * v0[2] + v0[3] * v0[3]) + (v1[0] * v1[0] + v1[1] * v1[1]) + (v1[2] * v1[2] + v1[3] * v1[3]);
                }
                q += __shfl_xor(q, 16); q += __shfl_xor(q, 32);
                if (fq == 0) (void)__hip_atomic_fetch_add(oss + rb + ai * 128 + m * 16, q, __ATOMIC_RELAXED, __HIP_MEMORY_SCOPE_AGENT);
            }
        const int c0 = u.pn * 256 + wc * 32 + 8 * fq;
        f32x4 gp[2][2];
#pragma unroll
        for (int bj = 0; bj < 2; ++bj) { gp[bj][0] = *(const f32x4*)(gpost + c0 + bj * 128); gp[bj][1] = *(const f32x4*)(gpost + c0 + bj * 128 + 4); }
        f32x4 pre[2][2][2];
#pragma unroll
        for (int m = 0; m < 2; ++m)
#pragma unroll
            for (int bj = 0; bj < 2; ++bj) { const size_t off = (size_t)(rb + m * 16) * DM + c0 + bj * 128; pre[m][bj][0] = __builtin_nontemporal_load((const f32x4*)(xp + off)); pre[m][bj][1] = __builtin_nontemporal_load((const f32x4*)(xp + off + 4)); }
        asm volatile("s_waitcnt vmcnt(0)" ::: "memory");
        __builtin_amdgcn_s_barrier();
        if (threadIdx.x == 0) {
            unsigned* cw = cnt + 64 * u.pm;
            (void)__hip_atomic_fetch_add(cw, 1u, __ATOMIC_RELAXED, __HIP_MEMORY_SCOPE_AGENT);
            unsigned sp = 0;
            while (__hip_atomic_load(cw, __ATOMIC_RELAXED, __HIP_MEMORY_SCOPE_AGENT) < 16u) { __builtin_amdgcn_s_sleep(2); if (++sp > (1u << 22)) break; }
        }
        __builtin_amdgcn_s_barrier();
        asm volatile("" ::: "memory");
#pragma unroll
        for (int ai = 0; ai < 2; ++ai)
#pragma unroll
            for (int m = 0; m < 4; ++m) {
                const int row = rb + ai * 128 + m * 16;
                const float tot = __hip_atomic_load(oss + row, __ATOMIC_RELAXED, __HIP_MEMORY_SCOPE_AGENT);
                const float rs = rsqrtf(tot * (1.0f / DM) + EPS);
#pragma unroll
                for (int bj = 0; bj < 2; ++bj) {
                    const size_t off = (size_t)row * DM + c0 + bj * 128;
                    const f32x4 x0 = (ai == 0 && m < 2) ? pre[m & 1][bj][0] : __builtin_nontemporal_load((const f32x4*)(xp + off)), x1 = (ai == 0 && m < 2) ? pre[m & 1][bj][1] : __builtin_nontemporal_load((const f32x4*)(xp + off + 4));
                    __builtin_nontemporal_store(x0 + acc[ai][bj][m][0] * rs * gp[bj][0], (f32x4*)(y + off)); __builtin_nontemporal_store(x1 + acc[ai][bj][m][1] * rs * gp[bj][1], (f32x4*)(y + off + 4));
                }
            }
    }
};
struct EpiSlab {
    bf16_t* F; int ldf, pm0, pn0; size_t slab;
    __device__ __forceinline__ void operator()(const f32x4 (&acc)[2][2][4][2], const pg8::Unit& u, int wr, int wc, int fr, int fq) const {
        asm volatile("" : "+v"(fr), "+v"(fq));
        const int rb = (u.pm - pm0) * 256 + wr * 64 + fr;
        bf16_t* base = F + (size_t)(u.koff >> 10) * slab + (u.pn - pn0) * 256 + wc * 32 + 8 * fq;
#pragma unroll
        for (int ai = 0; ai < 2; ++ai)
#pragma unroll
            for (int m = 0; m < 4; ++m) {
                bf16_t* rp = base + (size_t)(rb + ai * 128 + m * 16) * ldf;
#pragma unroll
                for (int bj = 0; bj < 2; ++bj) { const f32x4 v0 = acc[ai][bj][m][0], v1 = acc[ai][bj][m][1];
                    u32x4 w; w.x = cvt_pk_bf16(v0[0], v0[1]); w.y = cvt_pk_bf16(v0[2], v0[3]); w.z = cvt_pk_bf16(v1[0], v1[1]); w.w = cvt_pk_bf16(v1[2], v1[3]);
                    *(u32x4*)(rp + bj * 128) = w; }
            }
    }
};

template <class EF>
struct EpiMix {
    EF f; EpiSlab q;
    __device__ __forceinline__ void operator()(const f32x4 (&acc)[2][2][4][2], const pg8::Unit& u, int wr, int wc, int fr, int fq) const {
        if (u.kt == 64) f(acc, u, wr, wc, fr, fq); else q(acc, u, wr, wc, fr, fq);
    }
};

__device__ __forceinline__ void transpose_item64(const float* __restrict__ W, int N, bf16_t* __restrict__ WT, int K, int k0, int n0, int drow0, LAS float* scr, int lane, const float* rowscale = nullptr) {
    const int lr = lane >> 4, lc = (lane & 15) * 4;
    f32x4 v[16];
#pragma unroll
    for (int i = 0; i < 16; ++i) v[i] = __builtin_nontemporal_load((const f32x4*)(W + (size_t)(k0 + 4 * i + lr) * N + n0 + lc));
    if (rowscale) {
#pragma unroll
        for (int i = 0; i < 16; ++i) v[i] *= rowscale[k0 + 4 * i + lr];
    }
#pragma unroll
    for (int i = 0; i < 16; ++i) { LAS float* p = scr + (4 * i + lr) * 65 + lc; p[0] = v[i][0]; p[1] = v[i][1]; p[2] = v[i][2]; p[3] = v[i][3]; }
    LDS_WAIT();
    const int c = lane & 7, nr = lane >> 3;
#pragma unroll
    for (int j = 0; j < 8; ++j) {
        const int n = nr + 8 * j; const LAS float* s = scr + (8 * c) * 65 + n;
        u32x4 o; o.x = cvt_pk_bf16(s[0], s[65]); o.y = cvt_pk_bf16(s[130], s[195]); o.z = cvt_pk_bf16(s[260], s[325]); o.w = cvt_pk_bf16(s[390], s[455]);
        *(u32x4*)(WT + (size_t)(drow0 + n0 + n) * K + k0 + 8 * c) = o;
    }
    LDS_WAIT();
}
__device__ __forceinline__ int win_dest_row(int n) {
    if (n < 1536) return 256 * (n >> 7) + (n & 127);
    if (n < 3072) { n -= 1536; return 256 * (n >> 7) + 128 + (n & 127); }
    if (n < 4608) return 256 * 24 + (n - 3072);
    if (n < 6144) { n -= 4608; return 256 * (12 + (n >> 7)) + (n & 127); }
    if (n < 7680) return 256 * 30 + (n - 6144);
    if (n < 9216) { n -= 7680; return 256 * (12 + (n >> 7)) + 128 + (n & 127); }
    if (n < 10240) return 256 * 36 + (n - 9216);
    return 256 * 40 + (n - 10240);
}
__device__ __forceinline__ void rms_row_bf16(const float* __restrict__ xrow, const float* __restrict__ g, bf16_t* __restrict__ orow, int lane) {
    f32x4 v[16]; float s = 0.f;
#pragma unroll
    for (int j = 0; j < 16; ++j) { v[j] = __builtin_nontemporal_load((const f32x4*)xrow + lane + 64 * j); s += (v[j][0] * v[j][0] + v[j][1] * v[j][1]) + (v[j][2] * v[j][2] + v[j][3] * v[j][3]); }
    s = wave_sum(s);
    const float r = rsqrtf(s * (1.0f / DM) + EPS);
#pragma unroll
    for (int j = 0; j < 16; ++j) {
        const f32x4 gg = ((const f32x4*)g)[lane + 64 * j];
        u32x2 o; o.x = cvt_pk_bf16(v[j][0] * r * gg[0], v[j][1] * r * gg[1]); o.y = cvt_pk_bf16(v[j][2] * r * gg[2], v[j][3] * r * gg[3]);
        ((u32x2*)orow)[lane + 64 * j] = o;
    }
}

#define XB_TMO      128
#define XB_XCNT(j)  (256  + 64 * (j))
#define XB_XSUB(j)  (1280 + 64 * (j))
#define XB_XGEN(j)  (2304 + 64 * (j))
#define XB_TOP      3328
#define XB_TOPGEN   3392
#define XB_SPIN_CAP (1u << 20)
__device__ __forceinline__ unsigned xb_ld(unsigned* p)              { return __hip_atomic_load(p, __ATOMIC_RELAXED, __HIP_MEMORY_SCOPE_AGENT); }
__device__ __forceinline__ unsigned xb_add(unsigned* p, unsigned v) { return __hip_atomic_fetch_add(p, v, __ATOMIC_RELAXED, __HIP_MEMORY_SCOPE_AGENT); }
__device__ __forceinline__ unsigned xb_xcc_id() { return (unsigned)__builtin_amdgcn_s_getreg((3 << 11) | 20) & 0xFu; }
#define XB_SPIN(cond, bar) do { unsigned _sp = 0; while (cond) { __builtin_amdgcn_s_sleep(1); \
    if ((++_sp & 255u) == 0u) { if (xb_ld(&(bar)[XB_TMO])) break; if (_sp > XB_SPIN_CAP) { atomicAdd(&(bar)[XB_TMO], 1u); break; } } } } while (0)
struct XcdBarrier { unsigned* bar; unsigned x; volatile LAS unsigned* st; };
__device__ __forceinline__ XcdBarrier xcd_barrier_post(unsigned* bar, volatile LAS unsigned* st) {
    XcdBarrier b; b.bar = bar; b.x = xb_xcc_id(); b.st = st;
    if (threadIdx.x == 0) (void)xb_add(&bar[XB_XCNT(b.x)], 1u);
    return b;
}
__device__ __forceinline__ void xcd_barrier_complete(unsigned* bar, unsigned x, unsigned& nloc, unsigned& nx) {
    const unsigned G = gridDim.x * gridDim.y * gridDim.z;
    unsigned sum, cnt, mine, sp = 0u;
    for (;;) {
        sum = 0u; cnt = 0u; mine = 0u;
#pragma unroll
        for (unsigned j = 0; j < 16; ++j) { const unsigned c = xb_ld(&bar[XB_XCNT(j)]); sum += c; cnt += (c > 0u) ? 1u : 0u; mine = (j == x) ? c : mine; }
        if (sum == G) break;
        __builtin_amdgcn_s_sleep(1);
        if ((++sp & 255u) == 0u) { if (xb_ld(&bar[XB_TMO])) break; if (sp > XB_SPIN_CAP) { atomicAdd(&bar[XB_TMO], 1u); break; } }
    }
    nloc = mine > 0u ? mine : 1u; nx = cnt > 0u ? cnt : 1u;
}
__device__ __forceinline__ void xcd_barrier(const XcdBarrier& b) {
    asm volatile("s_waitcnt vmcnt(0)" ::: "memory");
    __syncthreads();
    if (threadIdx.x == 0) {
        unsigned* bar = b.bar;
        __builtin_amdgcn_s_waitcnt(0);
        unsigned nloc = b.st[0], nx = b.st[1];
        if (nloc == 0u) { xcd_barrier_complete(bar, b.x, nloc, nx); b.st[0] = nloc; b.st[1] = nx; }
        const unsigned old = xb_add(&bar[XB_XSUB(b.x)], 1u);
        const unsigned gen = old / nloc;
        if (old + 1u == (gen + 1u) * nloc) {
            __builtin_amdgcn_fence(__ATOMIC_RELEASE, "agent");
            asm volatile("s_waitcnt vmcnt(0)" ::: "memory");
            const unsigned og = xb_add(&bar[XB_TOP], 1u);
            const unsigned tg = og / nx;
            if (og + 1u == (tg + 1u) * nx) xb_add(&bar[XB_TOPGEN], 1u);
            else XB_SPIN(xb_ld(&bar[XB_TOPGEN]) == tg, bar);
            __builtin_amdgcn_fence(__ATOMIC_ACQUIRE, "agent");
            xb_add(&bar[XB_XGEN(b.x)], 1u);
            asm volatile("s_waitcnt vmcnt(0)" ::: "memory");
        } else {
            XB_SPIN(xb_ld(&bar[XB_XGEN(b.x)]) == gen, bar);
            __builtin_amdgcn_fence(__ATOMIC_ACQUIRE, "agent");
            asm volatile("s_waitcnt vmcnt(0)" ::: "memory");
        }
    }
    __syncthreads();
}

struct Args {
    const float* in[22]; float* out; unsigned char* ws;
};

constexpr int KVB = 512;
__device__ __forceinline__ int kv_off(int row, int chunk) { return row * KVB + ((chunk ^ ((row & 15) ^ (((row >> 4) & 1) << 2))) << 4); }
constexpr int KVH = 128 * KVB;
__device__ __forceinline__ void attn_dma(const bf16_t* base, int pitch, LAS unsigned char* buf, int wave, int lane) {
#pragma unroll
    for (int i = 0; i < 8; ++i) {
        const int r = 2 * (8 * wave + i) + (lane >> 5), cs = lane & 31, cg = cs ^ ((r & 15) ^ (((r >> 4) & 1) << 2));
        __builtin_amdgcn_global_load_lds((const unsigned*)(base + (size_t)r * pitch + cg * 8), (LAS unsigned*)(buf + (8 * wave + i) * 1024), 16, 0, 0);
    }
}
#define ATTN_LAND() do { asm volatile("s_waitcnt vmcnt(0)" ::: "memory"); __syncthreads(); } while (0)
__device__ __forceinline__ float attn_epi8(const f32x4 (&o)[8], float inv, const bf16_t* P, bf16_t* MIX, int qrow, int c0, int g) {
    float ss = 0.f;
#pragma unroll
    for (int p = 0; p < 4; ++p) {
        const int c = c0 + 32 * p + 8 * g;
        const u32x4 sg = *(const u32x4*)(P + (size_t)qrow * PW + P_SGX + c);
        f32x4 y0 = o[2 * p] * inv, y1 = o[2 * p + 1] * inv;
        y0[0] *= bflo(sg.x); y0[1] *= bfhi(sg.x); y0[2] *= bflo(sg.y); y0[3] *= bfhi(sg.y);
        y1[0] *= bflo(sg.z); y1[1] *= bfhi(sg.z); y1[2] *= bflo(sg.w); y1[3] *= bfhi(sg.w);
        ss += ((y0[0] * y0[0] + y0[1] * y0[1]) + (y0[2] * y0[2] + y0[3] * y0[3])) + ((y1[0] * y1[0] + y1[1] * y1[1]) + (y1[2] * y1[2] + y1[3] * y1[3]));
        u32x4 w; w.x = cvt_pk_bf16(y0[0], y0[1]); w.y = cvt_pk_bf16(y0[2], y0[3]); w.z = cvt_pk_bf16(y1[0], y1[1]); w.w = cvt_pk_bf16(y1[2], y1[3]);
        *(u32x4*)(MIX + (size_t)qrow * DM + 3072 + c) = w;
    }
    return ss;
}
__device__ __forceinline__ void attn_unit(int a, const bf16_t* P, const bf16_t* QF, const bf16_t* KB, const bf16_t* VTM, const float* g_branch,
                                          bf16_t* MIX, LAS unsigned char* kv, int tid, int wave, int lane) {
    int row0, bm, nq;
    if (a < 64) { row0 = a * 128; bm = a >> 5; nq = 8; } else { row0 = MP + (a - 64) * 64; bm = 2 + (a - 64); nq = 4; }
    const bool active = wave < nq;
    const int l150 = lane & 15, g0 = lane >> 4, l15 = l150, g = g0;
    const int qrow = row0 + 16 * (active ? wave : 0) + l15;
    const bf16_t* kg = KB + (size_t)(bm * 256) * 1024;
    const bf16_t* vg = VTM + (size_t)(bm * 4) * 256 * 256;
    const int krow0 = 8 * (l15 >> 2) + (l15 & 3);
    LAS unsigned char* bufA = kv; LAS unsigned char* bufB = kv + KVH;
    attn_dma(kg, 1024, bufA, wave, opq(lane));
    ATTN_LAND();
    float ss = 0.f;
#pragma unroll 1
    for (int h = 0; h < 4; ++h) {
        attn_dma(kg + h * 256 + (size_t)128 * 1024, 1024, bufB, wave, opq(lane));
        bf16x8 qf[8];
        if (active) {
            if (row0 < 4096) {
#pragma unroll
                for (int ks = 0; ks < 8; ++ks) {
                    const bf16_t* qp = QF + (size_t)qrow * CX + h * 256 + 32 * ks + 8 * g;
                    const u32x4 p0 = *(const u32x4*)qp, p1 = *(const u32x4*)(qp + SLAB), p2 = *(const u32x4*)(qp + 2 * SLAB), p3 = *(const u32x4*)(qp + 3 * SLAB);
                    u32x4 w;
#pragma unroll
                    for (int e = 0; e < 4; ++e) w[e] = cvt_pk_bf16(((bflo(p0[e]) + bflo(p1[e])) + (bflo(p2[e]) + bflo(p3[e]))) * QSCALE, ((bfhi(p0[e]) + bfhi(p1[e])) + (bfhi(p2[e]) + bfhi(p3[e]))) * QSCALE);
                    qf[ks] = __builtin_bit_cast(bf16x8, w);
                }
            } else {
#pragma unroll
                for (int ks = 0; ks < 8; ++ks) qf[ks] = *(const bf16x8*)(P + (size_t)qrow * PW + P_Q + h * 256 + 32 * ks + 8 * g);
            }
        }
        f32x4 s[16];
        if (active) {
            const int krow = opq(krow0), g = opq(g0);
#pragma unroll
            for (int kt = 0; kt < 16; ++kt) s[kt] = (f32x4){0.f, 0.f, 0.f, 0.f};
#pragma unroll
            for (int ks = 0; ks < 8; ++ks)
                {
#pragma unroll
                  for (int kt = 0; kt < 8; ++kt) s[kt] = __builtin_amdgcn_mfma_f32_16x16x32_bf16(*(const LAS bf16x8*)(bufA + kv_off(32 * (kt >> 1) + 4 * (kt & 1) + krow, 4 * ks + g)), qf[ks], s[kt], 0, 0, 0);
                  __builtin_amdgcn_sched_barrier(0); }
        }
        ATTN_LAND();
        attn_dma(vg + (size_t)h * 256 * 256, 256, bufA, wave, opq(lane));
        bf16x8 pf[8]; float inv = 0.f;
        if (active) {
            const int krow = opq(krow0), g = opq(g0);
#pragma unroll
            for (int ks = 0; ks < 8; ++ks)
                {
#pragma unroll
                  for (int kt = 8; kt < 16; ++kt) s[kt] = __builtin_amdgcn_mfma_f32_16x16x32_bf16(*(const LAS bf16x8*)(bufB + kv_off(32 * ((kt - 8) >> 1) + 4 * (kt & 1) + krow, 4 * ks + g)), qf[ks], s[kt], 0, 0, 0);
                  __builtin_amdgcn_sched_barrier(0); }
            float mx = s[0][0];
#pragma unroll
            for (int kt = 0; kt < 16; ++kt)
#pragma unroll
                for (int j = 0; j < 4; ++j) mx = fmaxf(mx, s[kt][j]);
            mx = fmaxf(mx, __shfl_xor(mx, 16)); mx = fmaxf(mx, __shfl_xor(mx, 32));
            float l = 0.f;
#pragma unroll
            for (int kt = 0; kt < 16; ++kt)
#pragma unroll
                for (int j = 0; j < 4; ++j) { const float p = __builtin_amdgcn_exp2f(s[kt][j] - mx); s[kt][j] = p; l += p; }
            l += __shfl_xor(l, 16); l += __shfl_xor(l, 32);
            inv = 1.0f / l;
#pragma unroll
            for (int si = 0; si < 8; ++si) {
                u32x4 w; w.x = cvt_pk_bf16(s[2 * si][0], s[2 * si][1]); w.y = cvt_pk_bf16(s[2 * si][2], s[2 * si][3]);
                w.z = cvt_pk_bf16(s[2 * si + 1][0], s[2 * si + 1][1]); w.w = cvt_pk_bf16(s[2 * si + 1][2], s[2 * si + 1][3]);
                pf[si] = __builtin_bit_cast(bf16x8, w);
            }
        }
        ATTN_LAND();
        attn_dma(vg + (size_t)h * 256 * 256 + (size_t)128 * 256, 256, bufB, wave, opq(lane));
        if (active) {
            const int krow = opq(krow0), g = opq(g0);
            f32x4 o[8];
#pragma unroll
            for (int dt = 0; dt < 8; ++dt) o[dt] = (f32x4){0.f, 0.f, 0.f, 0.f};
#pragma unroll
            for (int si = 0; si < 8; ++si)
                {
#pragma unroll
                  for (int dt = 0; dt < 8; ++dt) o[dt] = __builtin_amdgcn_mfma_f32_16x16x32_bf16(*(const LAS bf16x8*)(bufA + kv_off(32 * (dt >> 1) + 4 * (dt & 1) + krow, 4 * si + g)), pf[si], o[dt], 0, 0, 0);
                  __builtin_amdgcn_sched_barrier(0); }
            ss += attn_epi8(o, inv, P, MIX, qrow, h * 256, g);
        }
        ATTN_LAND();
        if (h < 3) attn_dma(kg + (h + 1) * 256, 1024, bufA, wave, opq(lane));
        if (active) {
            const int krow = opq(krow0), g = opq(g0);
            f32x4 o[8];
#pragma unroll
            for (int dt = 0; dt < 8; ++dt) o[dt] = (f32x4){0.f, 0.f, 0.f, 0.f};
#pragma unroll
            for (int si = 0; si < 8; ++si)
                {
#pragma unroll
                  for (int dt = 0; dt < 8; ++dt) o[dt] = __builtin_amdgcn_mfma_f32_16x16x32_bf16(*(const LAS bf16x8*)(bufB + kv_off(32 * (dt >> 1) + 4 * (dt & 1) + krow, 4 * si + g)), pf[si], o[dt], 0, 0, 0);
                  __builtin_amdgcn_sched_barrier(0); }
            ss += attn_epi8(o, inv, P, MIX, qrow, h * 256 + 128, g);
        }
        ATTN_LAND();
    }
    if (active) {
        ss += __shfl_xor(ss, 16); ss += __shfl_xor(ss, 32);
        const float rs = rsqrtf(ss * (1.0f / CX) + EPS);
        asm volatile("s_waitcnt vmcnt(0)" ::: "memory");
#pragma unroll 1
        for (int b = 0; b < 4; ++b) {
            bf16_t* mp = MIX + (size_t)qrow * DM + 3072 + 256 * b + 8 * g;
            u32x4 yv[8];
#pragma unroll
            for (int i = 0; i < 8; ++i) yv[i] = *(const u32x4*)(mp + 32 * i);
#pragma unroll
            for (int i = 0; i < 8; ++i) {
                u32x4 w; w.x = cvt_pk_bf16(bflo(yv[i].x) * rs, bfhi(yv[i].x) * rs); w.y = cvt_pk_bf16(bflo(yv[i].y) * rs, bfhi(yv[i].y) * rs);
                w.z = cvt_pk_bf16(bflo(yv[i].z) * rs, bfhi(yv[i].z) * rs); w.w = cvt_pk_bf16(bflo(yv[i].w) * rs, bfhi(yv[i].w) * rs);
                *(u32x4*)(mp + 32 * i) = w;
            }
        }
    }
    __syncthreads();
}

__device__ __forceinline__ void gmlp_unit(int u, const bf16_t* P, const bf16_t* VT, const float* vstat, const float* Ws, const float* bsp,
                                          const float* lvg, const float* lvb, const float* g_branch, float* GV, bf16_t* MIX,
                                          LAS float* sm, int tid, int wave, int lane) {
    int row0, ib; bool sample;
    if (u < 512) { row0 = (u >> 3) * 128; ib = u & 7; sample = false; } else { const int v = u - 512; row0 = MP + (v >> 2) * 64; ib = v & 3; sample = true; }
    const int i0 = 16 * ib, nks = (i0 + 47) >> 5, nj = i0 + 16;
    LAS float* sm_mean = sm; LAS float* sm_rstd = sm + 128; LAS float* sm_part = sm + 256;
    if (tid < 128) {
        float mean = 0.f, rstd = 0.f;
        if (tid < nj) { const float s1 = vstat[2 * (row0 + tid)], s2 = vstat[2 * (row0 + tid) + 1]; mean = s1 * (1.0f / CC); const float var = fmaxf(s2 * (1.0f / CC) - mean * mean, 0.f); rstd = rsqrtf(var + EPS); }
        sm_mean[tid] = mean; sm_rstd[tid] = rstd;
    }
    __syncthreads();
    if (sample && GV) {
        float* gv = GV + (size_t)(row0 - MP + i0) * CC;
        for (int e = tid; e < 16 * 384; e += NTHREADS) {
            const int r = e / 384, c4 = (e - r * 384) * 4;
            f32x4 v = *(f32x4*)(gv + (size_t)r * CC + c4); const f32x4 gg = *(const f32x4*)(lvg + c4), bb = *(const f32x4*)(lvb + c4);
            const float mean = sm_mean[i0 + r], rstd = sm_rstd[i0 + r];
            v = (v - mean) * rstd * gg + bb;
            *(f32x4*)(gv + (size_t)r * CC + c4) = v;
        }
    }
    const int h = wave >> 1, cw0 = 192 * wave, l15 = lane & 15, g = lane >> 4;
    const int i = i0 + l15;
    bf16x8 wf[4]; float c1 = 0.f, c2 = 0.f;
    {
        const float* wrow = Ws + ((size_t)h * 128 + i) * 128;
#pragma unroll
        for (int ks = 0; ks < 4; ++ks) {
            u32x4 w = (u32x4){0u, 0u, 0u, 0u};
            if (ks < nks) {
                const int j0 = 32 * ks + 8 * g; const f32x4 w0 = *(const f32x4*)(wrow + j0), w1 = *(const f32x4*)(wrow + j0 + 4);
                const f32x4 r0 = *(const LAS f32x4*)(sm_rstd + j0), r1 = *(const LAS f32x4*)(sm_rstd + j0 + 4), m0 = *(const LAS f32x4*)(sm_mean + j0), m1 = *(const LAS f32x4*)(sm_mean + j0 + 4);
                float wv[8] = {w0[0], w0[1], w0[2], w0[3], w1[0], w1[1], w1[2], w1[3]};
                const float rv[8] = {r0[0], r0[1], r0[2], r0[3], r1[0], r1[1], r1[2], r1[3]}, mv[8] = {m0[0], m0[1], m0[2], m0[3], m1[0], m1[1], m1[2], m1[3]};
#pragma unroll
                for (int e = 0; e < 8; ++e) { const int j = j0 + e; const float wm = (j <= i) ? wv[e] : 0.f; const float wp = wm * rv[e]; c1 += wp * mv[e]; c2 += wm; wv[e] = wp; }
                w.x = cvt_pk_bf16(wv[0], wv[1]); w.y = cvt_pk_bf16(wv[2], wv[3]); w.z = cvt_pk_bf16(wv[4], wv[5]); w.w = cvt_pk_bf16(wv[6], wv[7]);
            }
            wf[ks] = __builtin_bit_cast(bf16x8, w);
        }
        c1 += __shfl_xor(c1, 16); c1 += __shfl_xor(c1, 32); c2 += __shfl_xor(c2, 16); c2 += __shfl_xor(c2, 32);
    }
    f32x4 z[12];
#pragma unroll
    for (int nt = 0; nt < 12; ++nt) z[nt] = (f32x4){0.f, 0.f, 0.f, 0.f};
#pragma unroll
    for (int nt = 0; nt < 12; ++nt) {
        const bf16_t* vp = VT + (size_t)(cw0 + 16 * nt + l15) * MT + row0 + 8 * g;
#pragma unroll
        for (int ks = 0; ks < 4; ++ks) if (ks < nks) {
            const bf16x8 vf = *(const bf16x8*)(vp + 32 * ks);
            z[nt] = __builtin_amdgcn_mfma_f32_16x16x32_bf16(vf, wf[ks], z[nt], 0, 0, 0);
        }
    }
    const float bs = bsp[h * 128 + i];
    const int row = row0 + i;
    float ss = 0.f;
#pragma unroll
    for (int nt = 0; nt < 12; ++nt) {
        const int c = cw0 + 16 * nt + 4 * g; const f32x4 gv = *(const f32x4*)(lvg + c), bv = *(const f32x4*)(lvb + c);
        const u32x2 ug = *(const u32x2*)(P + (size_t)row * PW + P_UG + c);
        const float uu[4] = {bflo(ug.x), bfhi(ug.x), bflo(ug.y), bfhi(ug.y)};
        f32x4 y;
#pragma unroll
        for (int j = 0; j < 4; ++j) { const float zz = gv[j] * (z[nt][j] - c1) + bv[j] * c2 + bs; y[j] = uu[j] * zz; }
        z[nt] = y; ss += (y[0] * y[0] + y[1] * y[1]) + (y[2] * y[2] + y[3] * y[3]);
    }
    ss += __shfl_xor(ss, 16); ss += __shfl_xor(ss, 32);
    if (g == 0) sm_part[wave * 16 + l15] = ss;
    __syncthreads();
    {
        float tot = 0.f;
#pragma unroll
        for (int w = 0; w < 8; ++w) tot += sm_part[w * 16 + l15];
        const float rs = rsqrtf(tot * (1.0f / CC) + EPS);
#pragma unroll
        for (int nt = 0; nt < 12; ++nt) {
            const int c = cw0 + 16 * nt + 4 * g;
            const f32x4 y = z[nt] * rs;
            u32x2 w; w.x = cvt_pk_bf16(y[0], y[1]); w.y = cvt_pk_bf16(y[2], y[3]);
            *(u32x2*)(MIX + (size_t)row * DM + CC + c) = w;
        }
    }
    __syncthreads();
}

__device__ __forceinline__ void conv_unit(int a, const bf16_t* P, const bf16_t* GLU, const float* cw, const float* cb,
                                          const float* lg, const float* lb, const float* g_branch, bf16_t* MIX,
                                          LAS float* cbuf, int tid, int wave, int lane) {
    const int row0 = 16 * a;
    const bf16_t* gbase = GLU + (size_t)(glu_row(row0) - 30) * CC;
    const __amdgpu_buffer_rsrc_t rx = __builtin_amdgcn_make_buffer_rsrc((void*)gbase, 0, 46 * CC * 2, 0x00020000);
    const __amdgpu_buffer_rsrc_t rw = __builtin_amdgcn_make_buffer_rsrc((void*)cw, 0, 31 * CC * 4, 0x00020000);
#pragma unroll 1
    for (int it = 0; it < 2; ++it) {
        const int cp = tid + 512 * it;
        if (cp < CC / 2) {
            float w[31][2];
#pragma unroll
            for (int j = 0; j < 31; ++j) { w[j][0] = __builtin_bit_cast(float, __builtin_amdgcn_raw_buffer_load_b32(rw, cp * 8, j * CC * 4, 0)); w[j][1] = __builtin_bit_cast(float, __builtin_amdgcn_raw_buffer_load_b32(rw, cp * 8 + 4, j * CC * 4, 0)); }
            float acc[16][2];
            const float b0 = cb[2 * cp], b1 = cb[2 * cp + 1];
#pragma unroll
            for (int tt = 0; tt < 16; ++tt) { acc[tt][0] = b0; acc[tt][1] = b1; }
#pragma unroll
            for (int r = 0; r < 46; ++r) {
                const unsigned xv = (unsigned)__builtin_amdgcn_raw_buffer_load_b32(rx, cp * 4, r * CC * 2, 0);
                const float x0 = bflo(xv), x1 = bfhi(xv);
#pragma unroll
                for (int tt = 0; tt < 16; ++tt) if (r - tt >= 0 && r - tt <= 30) { acc[tt][0] += w[r - tt][0] * x0; acc[tt][1] += w[r - tt][1] * x1; }
            }
#pragma unroll
            for (int tt = 0; tt < 16; ++tt) { LAS float* d = cbuf + tt * CC + 2 * cp; d[0] = acc[tt][0]; d[1] = acc[tt][1]; }
        }
    }
    __syncthreads();
#pragma unroll
    for (int ti = 0; ti < 2; ++ti) {
        const int tt = 2 * wave + ti, row = row0 + tt;
        f32x4 v[6]; float s1 = 0.f, s2 = 0.f;
#pragma unroll
        for (int i = 0; i < 6; ++i) { v[i] = *(const LAS f32x4*)(cbuf + tt * CC + 4 * lane + 256 * i);
            s1 += (v[i][0] + v[i][1]) + (v[i][2] + v[i][3]); s2 += (v[i][0] * v[i][0] + v[i][1] * v[i][1]) + (v[i][2] * v[i][2] + v[i][3] * v[i][3]); }
        s1 = wave_sum(s1); s2 = wave_sum(s2);
        const float mean = s1 * (1.0f / CC), var = fmaxf(s2 * (1.0f / CC) - mean * mean, 0.f), rstd = rsqrtf(var + EPS);
        float q = 0.f;
#pragma unroll
        for (int i = 0; i < 6; ++i) {
            const int c = 4 * lane + 256 * i;
            const f32x4 gg = *(const f32x4*)(lg + c), bb = *(const f32x4*)(lb + c);
            const u32x2 sg = *(const u32x2*)(P + (size_t)row * PW + P_SGC + c);
            const float sv[4] = {bflo(sg.x), bfhi(sg.x), bflo(sg.y), bfhi(sg.y)};
#pragma unroll
            for (int j = 0; j < 4; ++j) { float y = (v[i][j] - mean) * rstd * gg[j] + bb[j]; y = y * sigmoidf_(y) * sv[j]; v[i][j] = y; q += y * y; }
        }
        q = wave_sum(q);
        const float rs = rsqrtf(q * (1.0f / CC) + EPS);
#pragma unroll
        for (int i = 0; i < 6; ++i) {
            const int c = 4 * lane + 256 * i;
            const f32x4 y = v[i] * rs;
            u32x2 o; o.x = cvt_pk_bf16(y[0], y[1]); o.y = cvt_pk_bf16(y[2], y[3]);
            *(u32x2*)(MIX + (size_t)row * DM + c) = o;
        }
    }
    __syncthreads();
}

__global__ void __launch_bounds__(NTHREADS, 2) mega_fwd(Args args) {
    extern __shared__ __attribute__((aligned(16))) unsigned char lds_raw[];
    LAS unsigned char* lds = (LAS unsigned char*)lds_raw;
    cg::grid_group grid = cg::this_grid();
    const int tid = threadIdx.x, lane = tid & 63, wave = __builtin_amdgcn_readfirstlane(tid >> 6);
    const int G = gridDim.x, bx = blockIdx.x;
    unsigned char* ws = args.ws;
    float* out = args.out;
    const float* x_prompt = args.in[0]; const float* x_sample = args.in[1]; const float* mem_prompt = args.in[2];
    const float* cache_k = args.in[3]; const float* cache_v = args.in[4]; const float* cache_conv = args.in[5];
    const float* g_pre = args.in[6]; const float* w_in = args.in[7]; const float* conv_w = args.in[8]; const float* conv_b = args.in[9];
    const float* ln_conv_g = args.in[10]; const float* ln_conv_b = args.in[11]; const float* ln_v_g = args.in[12]; const float* ln_v_b = args.in[13];
    const float* w_spatial = args.in[14]; const float* b_spatial = args.in[15]; const float* g_mem = args.in[16]; const float* w_mk = args.in[17]; const float* w_mv = args.in[18];
    const float* g_branch = args.in[19]; const float* w_out = args.in[20]; const float* g_post = args.in[21];
    unsigned* ctl = (unsigned*)(ws + WS_CTL);
    volatile LAS unsigned* bst = (volatile LAS unsigned*)(lds + LDS_BYTES - 16);
    if (tid < 4) bst[tid] = 0u;
    __syncthreads();
    const XcdBarrier xbar = xcd_barrier_post((unsigned*)(ws + CTL_BAR), bst);
    float* vstat = (float*)(ws + CTL_VSTAT); float* oss = (float*)(ws + CTL_OSS);
    bf16_t* WT = (bf16_t*)(ws + WS_WT); bf16_t* WO = (bf16_t*)(ws + WS_WO); bf16_t* H = (bf16_t*)(ws + WS_H); bf16_t* PB = (bf16_t*)(ws + WS_P);
    bf16_t* VT = (bf16_t*)(ws + WS_VT); bf16_t* KB = (bf16_t*)(ws + WS_KB); bf16_t* VTM = (bf16_t*)(ws + WS_VTM); bf16_t* MIX = (bf16_t*)(ws + WS_MIX); bf16_t* OB = (bf16_t*)(ws + WS_OUT); bf16_t* GLU = (bf16_t*)(ws + WS_GLU); bf16_t* QF = (bf16_t*)(ws + WS_QF); bf16_t* OF = (bf16_t*)(ws + WS_OF);

#ifndef REP_P0
#define REP_P0 1
#endif
#ifndef REP_P2
#define REP_P2 1
#endif
#ifndef REP_P4
#define REP_P4 1
#endif
    for (int rep0 = 0; rep0 < REP_P0; ++rep0) {
        const int gw = bx * 8 + wave, NGW = G * 8;
        LAS float* scr = (LAS float*)(lds + wave * 16640);
        constexpr int I_IN = 64 * 176, I_MK = 64 * 16, I_CV = 16 * 64, NITEMS = I_IN + 2 * I_MK + I_CV;
        for (int it = gw; it < NITEMS; it += NGW) {
            int r = it;
            if (r < I_IN) { const int kb = r / 176, nb = r - kb * 176; transpose_item64(w_in, NIN, WT, DM, 64 * kb, 64 * nb, win_dest_row(64 * nb) - 64 * nb, scr, lane); continue; } r -= I_IN;
            if (r < I_MK) { const int kb = r >> 4, nb = r & 15; transpose_item64(w_mk, CX, WT, DM, 64 * kb, 64 * nb, NIN, scr, lane); continue; } r -= I_MK;
            if (r < I_MK) { const int kb = r >> 4, nb = r & 15; transpose_item64(w_mv, CX, WT, DM, 64 * kb, 64 * nb, NIN + CX, scr, lane); continue; } r -= I_MK;
            { const int b = r >> 6, q = r & 63, kb = q >> 4, nb = q & 15; transpose_item64(cache_v + (size_t)b * 256 * 1024, 1024, VTM + (size_t)(2 + b) * 1024 * 256, 256, 64 * kb, 64 * nb, 0, scr, lane); }
        }
        for (int m = gw; m < MT + MEMR; m += NGW) {
            const float* src; const float* gg;
            if (m < MP) { src = x_prompt + (size_t)m * DM; gg = g_pre; } else if (m < MT) { src = x_sample + (size_t)(m - MP) * DM; gg = g_pre; } else { src = mem_prompt + (size_t)(m - MT) * DM; gg = g_mem; }
            rms_row_bf16(src, gg, H + (size_t)m * DM, lane);
        }
        for (int i = gw * 64 + lane; i < 16 * 256 * 1024 / 4; i += NGW * 64) {
            const f32x4 v = __builtin_nontemporal_load((const f32x4*)cache_k + i);
            u32x2 o; o.x = cvt_pk_bf16(v[0], v[1]); o.y = cvt_pk_bf16(v[2], v[3]);
            ((u32x2*)(KB + (size_t)2 * 256 * 1024))[i] = o;
        }
        for (int i = gw * 64 + lane; i < 18 * 30 * CC / 4; i += NGW * 64) {
            const int hr = i / (CC / 4), c4 = i - hr * (CC / 4), b = hr / 30, r = hr - b * 30;
            u32x2 o = (u32x2){0u, 0u};
            if (b >= 2) { const f32x4 v = ((const f32x4*)cache_conv)[i - 2 * 30 * CC / 4]; o.x = cvt_pk_bf16(v[0], v[1]); o.y = cvt_pk_bf16(v[2], v[3]); }
            const int grow = (b < 2 ? b * 4126 : 8252 + (b - 2) * 94) + r;
            ((u32x2*)(GLU + (size_t)grow * CC))[c4] = o;
        }
    }
    if (gridDim.y == 0x7fffu) grid.sync();
    xcd_barrier(xbar);

    {
#ifndef NO_G1
        { pg8::Gemm g{H, WT, DM}; Sched1 S{bx}; EpiMix<Epi1> E{Epi1{PB, GLU, VT, vstat, out, KB, VTM}, EpiSlab{QF, CX, 0, 36, SLAB}};
          pg8::gemm_phase<EpiMix<Epi1>, Sched1>(lds, g, S, E); }
#endif
    }
    xcd_barrier(xbar);

    for (int rep2 = 0; rep2 < REP_P2; ++rep2) {
        LAS float* cbuf = (LAS float*)lds;
        LAS float* sm = (LAS float*)(lds + 135168);
        LAS int* sm_next = (LAS int*)(lds + 135168 + 4096);
        constexpr int NA = 80, NC = 576, NB = 576, NW = 512, NU = NA + NC + NB + NW;
        for (;;) {
            if (tid == 0) *sm_next = (int)atomicAdd(ctl + 64 * rep2, 1u);
            __syncthreads();
            const int u = __builtin_amdgcn_readfirstlane(*sm_next);
            __syncthreads();
            if (u >= NU) break;
            int tidv = tid, wv = wave;
            asm volatile("" : "+v"(tidv), "+s"(wv));
            tidv &= 511; wv &= 7;
            const int lanev = tidv & 63;
#ifndef P2_MASK
#define P2_MASK 7
#endif
            const int pmask = rep2 == 0 ? 7 : P2_MASK;
            if (u >= NA + NC + NB) {
                const int it = 8 * (u - NA - NC - NB) + wv;
                transpose_item64(w_out, DM, WO, DM, 64 * (it >> 6), 64 * (it & 63), 0, (LAS float*)(lds + wv * 16640), lanev, g_branch);
                __syncthreads();
            } else if (u < NA) {
                if (pmask & 1) {
#ifndef NO_ATTN
                attn_unit(u, PB, QF, KB, VTM, g_branch, MIX, lds, tidv, wv, lanev);
#endif
                }
            } else if (u >= NA + NB) {
                if (pmask & 2) {
#ifndef NO_CONV
                conv_unit(u - NA - NB, PB, GLU, conv_w, conv_b, ln_conv_g, ln_conv_b, g_branch, MIX, cbuf, tidv, wv, lanev);
#endif
                }
            } else {
                if (pmask & 4) {
#ifndef NO_GMLP
                gmlp_unit(u - NA, PB, VT, vstat, w_spatial, b_spatial, ln_v_g, ln_v_b, g_branch, rep2 == 0 ? out + O_GV : nullptr, MIX, sm, tidv, wv, lanev);
#endif
                }
            }
        }
    }
    xcd_barrier(xbar);

    {
#ifndef NO_G2
        { pg8::Gemm g{MIX, WO, DM}; Sched2 S{bx}; EpiMix<Epi2F> E{Epi2F{x_prompt, g_post, out + O_Y, oss, (unsigned*)(ws + CTL_PCNT)}, EpiSlab{OF, DM, 32, 0, SLAB}};
          pg8::gemm_phase<EpiMix<Epi2F>, Sched2>(lds, g, S, E); }
#endif
    }
    xcd_barrier(xbar);

    for (int rep4 = 0; rep4 < REP_P4; ++rep4) {
        const int lane = opq(tid) & 63;
        const int gw = bx * 8 + wave, NGW = G * 8;
        for (int m = MP + gw; m < MT; m += NGW) {
            float* yr = out + O_Y + (size_t)m * DM;
            if (m < MP) {
                const float* xr = x_prompt + (size_t)m * DM; const bf16_t* orow = OB + (size_t)m * DM;
                u32x4 ov[8]; f32x4 xv[16]; float q = 0.f;
#pragma unroll
                for (int j = 0; j < 8; ++j) ov[j] = *(const u32x4*)(orow + (lane + 64 * j) * 8);
#pragma unroll
                for (int j = 0; j < 8; ++j) { xv[2 * j] = *(const f32x4*)(xr + (lane + 64 * j) * 8); xv[2 * j + 1] = *(const f32x4*)(xr + (lane + 64 * j) * 8 + 4); }
#pragma unroll
                for (int j = 0; j < 8; ++j) {
                    const float a0 = bflo(ov[j].x), a1 = bfhi(ov[j].x), a2 = bflo(ov[j].y), a3 = bfhi(ov[j].y), a4 = bflo(ov[j].z), a5 = bfhi(ov[j].z), a6 = bflo(ov[j].w), a7 = bfhi(ov[j].w);
                    q += (a0 * a0 + a1 * a1) + (a2 * a2 + a3 * a3) + (a4 * a4 + a5 * a5) + (a6 * a6 + a7 * a7); }
                q = wave_sum(q);
                const float rs = rsqrtf(q * (1.0f / DM) + EPS);
#pragma unroll
                for (int j = 0; j < 8; ++j) {
                    const int c = (lane + 64 * j) * 8;
                    const f32x4 x0 = xv[2 * j], x1 = xv[2 * j + 1], g0 = *(const f32x4*)(g_post + c), g1 = *(const f32x4*)(g_post + c + 4);
                    f32x4 y0, y1;
                    y0[0] = x0[0] + bflo(ov[j].x) * rs * g0[0]; y0[1] = x0[1] + bfhi(ov[j].x) * rs * g0[1]; y0[2] = x0[2] + bflo(ov[j].y) * rs * g0[2]; y0[3] = x0[3] + bfhi(ov[j].y) * rs * g0[3];
                    y1[0] = x1[0] + bflo(ov[j].z) * rs * g1[0]; y1[1] = x1[1] + bfhi(ov[j].z) * rs * g1[1]; y1[2] = x1[2] + bflo(ov[j].w) * rs * g1[2]; y1[3] = x1[3] + bfhi(ov[j].w) * rs * g1[3];
                    *(f32x4*)(yr + c) = y0; *(f32x4*)(yr + c + 4) = y1;
                }
            } else {
                const float* xr = x_sample + (size_t)(m - MP) * DM; const bf16_t* orow = OF + (size_t)(m - MP) * DM;
                f32x4 ov[16]; float q = 0.f;
#pragma unroll
                for (int j = 0; j < 16; ++j) { const bf16_t* op = orow + (lane + 64 * j) * 4;
                    const u32x2 p0 = *(const u32x2*)op, p1 = *(const u32x2*)(op + SLAB), p2 = *(const u32x2*)(op + 2 * SLAB), p3 = *(const u32x2*)(op + 3 * SLAB);
                    ov[j][0] = (bflo(p0.x) + bflo(p1.x)) + (bflo(p2.x) + bflo(p3.x)); ov[j][1] = (bfhi(p0.x) + bfhi(p1.x)) + (bfhi(p2.x) + bfhi(p3.x));
                    ov[j][2] = (bflo(p0.y) + bflo(p1.y)) + (bflo(p2.y) + bflo(p3.y)); ov[j][3] = (bfhi(p0.y) + bfhi(p1.y)) + (bfhi(p2.y) + bfhi(p3.y));
                    q += (ov[j][0] * ov[j][0] + ov[j][1] * ov[j][1]) + (ov[j][2] * ov[j][2] + ov[j][3] * ov[j][3]); }
                q = wave_sum(q);
                const float rs = rsqrtf(q * (1.0f / DM) + EPS);
#pragma unroll
                for (int j = 0; j < 16; ++j) {
                    const int c = (lane + 64 * j) * 4;
                    const f32x4 x0 = __builtin_nontemporal_load((const f32x4*)(xr + c)), g0 = *(const f32x4*)(g_post + c);
                    __builtin_nontemporal_store(x0 + ov[j] * rs * g0, (f32x4*)(yr + c));
                }
            }
        }
    }
}

extern "C" void kernel_launch(void* const* d_in, const int* in_sizes, int n_in, void* d_out, int out_size, void* d_ws, size_t ws_size, hipStream_t stream) {
    static int grid = 0;
    if (grid == 0) {
        if (n_in != 22 || ws_size < WS_END) { fprintf(stderr, "kernel_launch: unexpected inputs (n_in %d, ws %zu)\n", n_in, ws_size); grid = -1; return; }
        int dev = 0, cus = 0, per_cu = 0;
        (void)hipGetDevice(&dev);
        (void)hipDeviceGetAttribute(&cus, hipDeviceAttributeMultiprocessorCount, dev);
        if (hipFuncSetAttribute((const void*)mega_fwd, hipFuncAttributeMaxDynamicSharedMemorySize, LDS_BYTES) != hipSuccess) { fprintf(stderr, "kernel_launch: hipFuncSetAttribute failed\n"); grid = -1; return; }
        if (hipOccupancyMaxActiveBlocksPerMultiprocessor(&per_cu, (const void*)mega_fwd, NTHREADS, LDS_BYTES) != hipSuccess || per_cu < 1) { fprintf(stderr, "kernel_launch: occupancy query says %d\n", per_cu); per_cu = 1; }
        (void)hipGetLastError();
        grid = 256;
        if (cus != 256) fprintf(stderr, "kernel_launch: built for a 256-CU device, found %d CUs\n", cus);
    }
    if (grid < 0) return;
    (void)hipMemsetAsync((char*)d_ws + WS_CTL, 0, CTL_BYTES, stream);
    Args a{};
    for (int i = 0; i < 22; ++i) a.in[i] = (const float*)d_in[i];
    a.out = (float*)d_out; a.ws = (unsigned char*)d_ws;
    void* kargs[] = {&a};
    hipError_t e = hipLaunchCooperativeKernel((const void*)mega_fwd, dim3(grid), dim3(NTHREADS), kargs, LDS_BYTES, stream);
    if (e != hipSuccess) fprintf(stderr, "kernel_launch: cooperative launch failed: %s (grid %d)\n", hipGetErrorString(e), grid);
}
```

```cpp
#include <hip/hip_runtime.h>
#include <hip/hip_cooperative_groups.h>
#include <cstdio>
#include <cstdint>
namespace cg = cooperative_groups;

#define LAS __attribute__((address_space(3)))
typedef unsigned short bf16_t;
typedef short bf16x8 __attribute__((ext_vector_type(8)));
typedef short s16x4 __attribute__((ext_vector_type(4)));
typedef float f32x4 __attribute__((ext_vector_type(4)));
typedef unsigned u32x4 __attribute__((ext_vector_type(4)));
typedef unsigned u32x2 __attribute__((ext_vector_type(2)));

constexpr int DM = 4096;
constexpr int MP = 8192, MS = 1024, MT = MP + MS;
constexpr int NIN = 11264;
constexpr int CC = 1536;
constexpr int CX = 1024;
constexpr int MEMR = 512;
constexpr float EPS = 1e-6f;
constexpr int PW = 5120;
constexpr int P_UG = 0, P_SGC = 1536, P_Q = 3072, P_SGX = 4096;
constexpr int GROWS = MT + 18 * 30;
__device__ __forceinline__ int glu_row(int row) { return row < MP ? row + 30 * ((row >> 12) + 1) : row + 30 * (((row - MP) >> 6) + 3); }
constexpr float QSCALE = 0.0625f * 1.4426950408889634f;

constexpr size_t O_Y = 0, O_MK = (size_t)MT * DM, O_MV = O_MK + 524288, O_CP = O_MV + 524288, O_CS = O_CP + 92160, O_GV = O_CS + 737280;

constexpr size_t MiB = 1u << 20;
constexpr size_t WS_CTL = 0, CTL_BYTES = 262144;
constexpr size_t CTL_BAR = 131072;
constexpr size_t CTL_PCNT = 196608;
constexpr size_t CTL_VSTAT = 4096, CTL_OSS = CTL_VSTAT + (size_t)MT * 8;
static_assert(CTL_OSS + (size_t)MT * 4 <= CTL_BYTES, "ctl");
constexpr size_t WS_WT = 2 * MiB;
constexpr size_t WS_WO = 106 * MiB;
constexpr size_t WS_H = 138 * MiB;
constexpr size_t WS_P = 214 * MiB;
constexpr size_t WS_VT = 332 * MiB;
constexpr size_t WS_KB = 360 * MiB;
constexpr size_t WS_VTM = 370 * MiB;
constexpr size_t WS_MIX = 380 * MiB;
constexpr size_t WS_OUT = 452 * MiB;
constexpr size_t WS_GLU = 524 * MiB;
constexpr size_t WS_QF = 556 * MiB;
constexpr size_t WS_OF = 620 * MiB;
constexpr size_t WS_END = 684 * MiB;
constexpr size_t SLAB = (size_t)4096 * 1024;
static_assert(WS_GLU + (size_t)GROWS * CC * 2 <= WS_END, "glu");
static_assert(WS_WT + (size_t)13312 * 4096 * 2 <= WS_WO && WS_WO + (size_t)4096 * 4096 * 2 <= WS_H && WS_H + (size_t)9728 * 4096 * 2 <= WS_P &&
              WS_P + (size_t)MT * PW * 2 <= WS_VT && WS_VT + (size_t)CC * MT * 2 <= WS_KB && WS_KB + (size_t)18 * 256 * 1024 * 2 <= WS_VTM &&
              WS_VTM + (size_t)18 * 1024 * 256 * 2 <= WS_MIX && WS_MIX + (size_t)MT * DM * 2 <= WS_OUT && WS_OUT + (size_t)MT * DM * 2 <= WS_END, "ws map");

constexpr int LDS_BYTES = 143360;
constexpr int NTHREADS = 512;

__device__ __forceinline__ unsigned cvt_pk_bf16(float lo, float hi) { unsigned r; asm volatile("v_cvt_pk_bf16_f32 %0, %1, %2" : "=v"(r) : "v"(lo), "v"(hi)); return r; }
__device__ __forceinline__ bf16_t f2bf(float f) { return (bf16_t)(cvt_pk_bf16(f, 0.f) & 0xffffu); }
__device__ __forceinline__ float bf2f(bf16_t u) { return __uint_as_float(((unsigned)u) << 16); }
__device__ __forceinline__ float bflo(unsigned u) { return __uint_as_float(u << 16); }
__device__ __forceinline__ float bfhi(unsigned u) { return __uint_as_float(u & 0xffff0000u); }
__device__ __forceinline__ float sigmoidf_(float x) { return __builtin_amdgcn_rcpf(1.0f + __builtin_amdgcn_exp2f(-1.4426950408889634f * x)); }
__device__ __forceinline__ float wave_sum(float v) {
#pragma unroll
    for (int o = 1; o < 64; o <<= 1) v += __shfl_xor(v, o);
    return v;
}
#define LDS_WAIT() asm volatile("s_waitcnt lgkmcnt(0)" ::: "memory")
__device__ __forceinline__ int opq(int x) { asm volatile("" : "+v"(x)); return x; }

namespace pg8 {
constexpr int BM = 256, BK = 64, HALF = 128, HTB = HALF * BK * 2, STAGE_BYTES = 8 * HTB;
__device__ __forceinline__ int lds_byte(int r, int c) { const int st = (r >> 4) * 2 + (c >> 5), rr = r & 15, cc = c & 31, ob = rr * 64 + cc * 2; return st * 1024 + (ob ^ (((ob >> 9) & 1) << 5)); }
__device__ __forceinline__ void stage_rc(int b, int& R, int& C) { const int st = b / 1024, sb = b % 1024, swz = sb ^ (((sb >> 9) & 1) << 5); R = (st >> 1) * 16 + swz / 64; C = (st & 1) * 32 + (swz % 64) / 2; }
__device__ __forceinline__ int perm32(int rho) { const int n = rho >> 4, i = rho & 15; return 8 * (i >> 2) + 4 * n + (i & 3); }
struct Unit { int pm, pn, koff, kt; };
struct Gemm { const bf16_t* A; const bf16_t* Bt; int ld; };

template <class Epi, class Sched>
__device__ __forceinline__ void gemm_phase(LAS unsigned char* lds, const Gemm g, const Sched& S, const Epi& E) {
    const int tid = opq((int)threadIdx.x) & 511, wid = __builtin_amdgcn_readfirstlane(tid >> 6), lane = tid & 63, wr = wid >> 2, wc = wid & 3, fr = lane & 15, fq = lane >> 4;
    const int K = g.ld;
    unsigned voffA[2], voffB[2];
#pragma unroll
    for (int i = 0; i < 2; ++i) { int R, C; stage_rc(tid * 16 + i * 8192, R, C); const int Rb = (R & ~31) + perm32(R & 31);
        voffA[i] = (unsigned)(R * K + C) * 2u; voffB[i] = (unsigned)(Rb * K + C) * 2u; }
    const size_t kstep = (size_t)(BK * 2);
    const size_t hstep = (size_t)HALF * K * 2;
    const size_t tstep = 2 * hstep;
    const unsigned ldsw = (unsigned)wid * 1024u;
    const int aoff = lds_byte(wr * 64 + fr, fq * 8), boff = lds_byte(wc * 32 + fr, fq * 8);
#define PG8_SA(b, h) (((b) * 2 + (h)) * HTB)
#define PG8_SB(b, h) ((4 + (b) * 2 + (h)) * HTB)
#define PG8_STAGE(bufoff, gbase, voff) do { _Pragma("unroll") for (int _i = 0; _i < 2; ++_i) \
        __builtin_amdgcn_global_load_lds((const unsigned*)((const char*)(gbase) + (voff)[_i]), (LAS unsigned*)(lds + (bufoff) + ldsw + _i * 8192), 16, 0, 0); } while (0)
#define PG8_LDA(dst, b, h) do { _Pragma("unroll") for (int m = 0; m < 4; ++m) _Pragma("unroll") for (int k = 0; k < 2; ++k) dst[m][k] = *(const LAS bf16x8*)(lds + PG8_SA(b, h) + aoff + m * 2048 + k * 1024); } while (0)
#define PG8_LDB(dst, b, h) do { _Pragma("unroll") for (int n = 0; n < 2; ++n) _Pragma("unroll") for (int k = 0; k < 2; ++k) dst[n][k] = *(const LAS bf16x8*)(lds + PG8_SB(b, h) + boff + n * 2048 + k * 1024); } while (0)
#define PG8_MMA(ai, bj, At, Bt) do { __builtin_amdgcn_s_setprio(1); _Pragma("unroll") for (int m = 0; m < 4; ++m) _Pragma("unroll") for (int n = 0; n < 2; ++n) _Pragma("unroll") for (int k = 0; k < 2; ++k) \
        acc[ai][bj][m][n] = __builtin_amdgcn_mfma_f32_16x16x32_bf16(Bt[n][k], At[m][k], acc[ai][bj][m][n], 0, 0, 0); __builtin_amdgcn_s_setprio(0); } while (0)
#define PG8_WAIT_V(n) asm volatile("s_waitcnt vmcnt(" #n ")" ::: "memory")
#define PG8_WAIT_L(n) asm volatile("s_waitcnt lgkmcnt(" #n ")" ::: "memory")
#define PG8_BAR __builtin_amdgcn_s_barrier()
#define PG8_SCHED __builtin_amdgcn_sched_barrier(0)
    Unit cur, nxt; int ui = 0;
    if (!S.next(0, cur)) return;
    f32x4 acc[2][2][4][2];
#pragma unroll
    for (int a = 0; a < 2; ++a)
#pragma unroll
        for (int b = 0; b < 2; ++b)
#pragma unroll
            for (int m = 0; m < 4; ++m)
#pragma unroll
                for (int n = 0; n < 2; ++n) acc[a][b][m][n] = (f32x4){0.f, 0.f, 0.f, 0.f};
    bf16x8 At[4][2], B0[2][2], B1[2][2];
    const char* cA = (const char*)g.A + (size_t)cur.pm * tstep + (size_t)cur.koff * 2; const char* cB = (const char*)g.Bt + (size_t)cur.pn * tstep + (size_t)cur.koff * 2;
    PG8_STAGE(PG8_SB(0, 0), cB, voffB); PG8_STAGE(PG8_SB(0, 1), cB + hstep, voffB); PG8_STAGE(PG8_SA(0, 0), cA, voffA); PG8_STAGE(PG8_SA(0, 1), cA + hstep, voffA);
    if (wr == 1) PG8_BAR;
    PG8_WAIT_V(2); PG8_BAR;
    PG8_STAGE(PG8_SB(1, 0), cB + kstep, voffB); PG8_STAGE(PG8_SA(1, 0), cA + kstep, voffA); PG8_STAGE(PG8_SB(1, 1), cB + hstep + kstep, voffB);
    PG8_WAIT_V(6); PG8_BAR;
    for (;;) {
        const bool has_next = S.next(ui + 1, nxt);
        const char* nA = has_next ? (const char*)g.A + (size_t)nxt.pm * tstep + (size_t)nxt.koff * 2 : cA; const char* nB = has_next ? (const char*)g.Bt + (size_t)nxt.pn * tstep + (size_t)nxt.koff * 2 : cB;
        const int nt = cur.kt;
        for (int t = 0; t < nt; t += 2) {
            const bool last = (t == nt - 2);
            const char* a1 = cA + (size_t)(t + 1) * kstep;
            const char* a2 = last ? nA : cA + (size_t)(t + 2) * kstep; const char* b2 = last ? nB : cB + (size_t)(t + 2) * kstep;
            const char* a3 = a2 + kstep; const char* b3 = b2 + kstep;
            PG8_LDB(B0, 0, 0); PG8_LDB(B1, 0, 1); PG8_SCHED; PG8_LDA(At, 0, 0); PG8_STAGE(PG8_SA(1, 1), a1 + hstep, voffA);
            PG8_WAIT_V(8); PG8_WAIT_L(0); PG8_BAR; PG8_MMA(0, 0, At, B0); PG8_MMA(0, 1, At, B1); PG8_BAR; PG8_SCHED;
            PG8_LDA(At, 0, 1); PG8_STAGE(PG8_SB(0, 0), b2, voffB); PG8_STAGE(PG8_SB(0, 1), b2 + hstep, voffB); PG8_STAGE(PG8_SA(0, 0), a2, voffA);
            PG8_WAIT_V(8); PG8_WAIT_L(0); PG8_BAR; PG8_MMA(1, 0, At, B0); PG8_MMA(1, 1, At, B1); PG8_BAR; PG8_SCHED;
            PG8_LDB(B0, 1, 0); PG8_LDB(B1, 1, 1); PG8_SCHED; PG8_LDA(At, 1, 0); PG8_STAGE(PG8_SA(0, 1), a2 + hstep, voffA);
            PG8_WAIT_V(8); PG8_WAIT_L(0); PG8_BAR; PG8_MMA(0, 0, At, B0); PG8_MMA(0, 1, At, B1); PG8_BAR; PG8_SCHED;
            PG8_LDA(At, 1, 1); PG8_STAGE(PG8_SB(1, 0), b3, voffB); PG8_STAGE(PG8_SB(1, 1), b3 + hstep, voffB); PG8_STAGE(PG8_SA(1, 0), a3, voffA);
            PG8_WAIT_V(8); PG8_WAIT_L(0); PG8_BAR; PG8_MMA(1, 0, At, B0); PG8_MMA(1, 1, At, B1); PG8_BAR; PG8_SCHED;
        }
        if (wr == 0) PG8_BAR;
        E(acc, cur, wr, wc, fr, fq);
        if (!has_next) break;
#pragma unroll
        for (int a = 0; a < 2; ++a)
#pragma unroll
            for (int b = 0; b < 2; ++b)
#pragma unroll
                for (int m = 0; m < 4; ++m)
#pragma unroll
                    for (int n = 0; n < 2; ++n) acc[a][b][m][n] = (f32x4){0.f, 0.f, 0.f, 0.f};
        cur = nxt; cA = nA; cB = nB; ++ui;
        if (wr == 1) PG8_BAR;
    }
    PG8_WAIT_V(0);
    PG8_BAR;
#undef PG8_SA
#undef PG8_SB
#undef PG8_STAGE
#undef PG8_LDA
#undef PG8_LDB
#undef PG8_MMA
#undef PG8_WAIT_V
#undef PG8_WAIT_L
#undef PG8_BAR
#undef PG8_SCHED
}
}

__device__ __forceinline__ void static_unit(int L, int nM, int nN, pg8::Unit& u) {
    const int nwg = nM * nN;
    int wgid = L; { const int q = nwg / 8, r = nwg % 8, xcd = wgid % 8, off = wgid / 8; wgid = (xcd < r ? xcd * (q + 1) : r * (q + 1) + (xcd - r) * q) + off; }
    const int nig = 8 * nN, gid = wgid / nig, fm = gid * 8, gsz = (nM - fm) < 8 ? (nM - fm) : 8;
    u.pm = fm + ((wgid % nig) % gsz); u.pn = (wgid % nig) / gsz; u.koff = 0; u.kt = 64;
}
__device__ __forceinline__ void g1_full_unit(int L, pg8::Unit& u) {
    pg8::Unit t; static_unit(L < 1440 ? L : 0, 36, 40, t); if (t.pn >= 36) t.pn += 4;
    const int r = L - 1440; const bool tail = L >= 1440, isq = r < 80;
    u.pm = tail ? (isq ? 16 + (r >> 2) : 36 + ((r - 80) >> 3)) : t.pm; u.pn = tail ? (isq ? 36 + (r & 3) : 44 + ((r - 80) & 7)) : t.pn; u.koff = 0; u.kt = 64;
}
struct Sched1 {
    int c;
    __device__ __forceinline__ bool next(int i, pg8::Unit& u) const {
        if (i >= 7) return false;
        const bool qfirst = (c & 4) != 0; const bool isq = (i == (qfirst ? 0 : 6));
        pg8::Unit f; g1_full_unit((qfirst ? (i > 0 ? i - 1 : 0) : (i < 6 ? i : 0)) * 256 + c, f);
        const int xcd = c & 7, j = c >> 3;
        u.pm = isq ? 2 * xcd + (j >> 4) : f.pm; u.pn = isq ? 36 + ((j & 15) >> 2) : f.pn; u.koff = isq ? 1024 * (j & 3) : 0; u.kt = isq ? 16 : 64;
        return true;
    }
};
struct Sched2 {
    int c;
    __device__ __forceinline__ bool next(int i, pg8::Unit& u) const {
        if (i >= 3) return false;
        const bool qfirst = (c & 4) != 0; const bool isq = (i == (qfirst ? 0 : 2));
        const int xcd = c & 7, j = c >> 3, r = qfirst ? i - 1 : i;
        u.pm = isq ? 32 + (xcd >> 1) : 16 * r + 2 * xcd + (j >> 4); u.pn = j & 15; u.koff = isq ? 1024 * (2 * (xcd & 1) + (j >> 4)) : 0; u.kt = isq ? 16 : 64;
        return true;
    }
};

struct Epi1 {
    bf16_t* P; bf16_t* GLU; bf16_t* VT; float* vstat; float* out; bf16_t* KB; bf16_t* VTM;
    __device__ __forceinline__ void operator()(const f32x4 (&acc)[2][2][4][2], const pg8::Unit& u, int wr, int wc, int fr, int fq) const {
        asm volatile("" : "+v"(fr), "+v"(fq));
        const int pm = u.pm, pn = u.pn;
        const int rb = pm * 256 + wr * 64 + fr;
        const int cl = wc * 32 + 8 * fq;
        if (pn < 24) {
            const bool isglu = pn < 12; const int t = isglu ? pn : pn - 12;
            bf16_t* base = (isglu ? GLU : P + P_UG) + t * 128 + cl;
#pragma unroll
            for (int ai = 0; ai < 2; ++ai)
#pragma unroll
                for (int m = 0; m < 4; ++m) {
                    const int row = rb + ai * 128 + m * 16;
                    f32x4 r0, r1; const f32x4 x0 = acc[ai][0][m][0], x1 = acc[ai][0][m][1], g0 = acc[ai][1][m][0], g1 = acc[ai][1][m][1];
#pragma unroll
                    for (int j = 0; j < 4; ++j) {
                        float s0 = sigmoidf_(g0[j]), s1 = sigmoidf_(g1[j]);
                        if (!isglu) { s0 *= g0[j]; s1 *= g1[j]; }
                        r0[j] = x0[j] * s0; r1[j] = x1[j] * s1;
                    }
                    u32x4 w; w.x = cvt_pk_bf16(r0[0], r0[1]); w.y = cvt_pk_bf16(r0[2], r0[3]); w.z = cvt_pk_bf16(r1[0], r1[1]); w.w = cvt_pk_bf16(r1[2], r1[3]);
                    __builtin_nontemporal_store(w, (u32x4*)(base + (isglu ? (size_t)glu_row(row) * CC : (size_t)row * PW)));
                    if (isglu) {
                        float* dst = nullptr;
                        if (row < MP) { const int tt = row & 4095; if (tt >= 4066) dst = out + O_CP + ((size_t)(row >> 12) * 30 + (tt - 4066)) * CC; }
                        else { const int rr = row - MP, tt = rr & 63; if (tt >= 34) dst = out + O_CS + ((size_t)(rr >> 6) * 30 + (tt - 34)) * CC; }
                        if (dst) { dst += t * 128 + cl; *(f32x4*)dst = r0; *(f32x4*)(dst + 4) = r1; }
                    }
                }
        } else if (pn < 30 || (pn >= 36 && pn < 44)) {
            int cb; bool act = true;
            if (pn < 30) cb = P_SGC + (pn - 24) * 256; else if (pn < 40) { cb = P_Q + (pn - 36) * 256; act = false; } else cb = P_SGX + (pn - 40) * 256;
            bf16_t* base = P + cb + cl;
#pragma unroll
            for (int ai = 0; ai < 2; ++ai)
#pragma unroll
                for (int m = 0; m < 4; ++m) {
                    const int row = rb + ai * 128 + m * 16;
#pragma unroll
                    for (int bj = 0; bj < 2; ++bj) {
                        f32x4 v0 = acc[ai][bj][m][0], v1 = acc[ai][bj][m][1];
#pragma unroll
                        for (int j = 0; j < 4; ++j) {
                            if (act) { v0[j] *= sigmoidf_(v0[j]); v1[j] *= sigmoidf_(v1[j]); } else { v0[j] *= QSCALE; v1[j] *= QSCALE; }
                        }
                        u32x4 w; w.x = cvt_pk_bf16(v0[0], v0[1]); w.y = cvt_pk_bf16(v0[2], v0[3]); w.z = cvt_pk_bf16(v1[0], v1[1]); w.w = cvt_pk_bf16(v1[2], v1[3]);
                        __builtin_nontemporal_store(w, (u32x4*)(base + (size_t)row * PW + bj * 128));
                    }
                }
        } else if (pn < 36) {
            const int c0 = (pn - 30) * 256 + cl;
#pragma unroll
            for (int ai = 0; ai < 2; ++ai)
#pragma unroll
                for (int m = 0; m < 4; ++m) {
                    const int row = rb + ai * 128 + m * 16;
                    float s = 0.f, q = 0.f;
#pragma unroll
                    for (int bj = 0; bj < 2; ++bj)
#pragma unroll
                        for (int n = 0; n < 2; ++n) {
                            const f32x4 v = acc[ai][bj][m][n];
#pragma unroll
                            for (int j = 0; j < 4; ++j) { s += v[j]; q += v[j] * v[j]; VT[(size_t)(c0 + bj * 128 + 4 * n + j) * MT + row] = f2bf(v[j]); }
                        }
                    s += __shfl_xor(s, 16); s += __shfl_xor(s, 32); q += __shfl_xor(q, 16); q += __shfl_xor(q, 32);
                    if (fq == 0) { atomicAdd(vstat + 2 * row, s); atomicAdd(vstat + 2 * row + 1, q); }
                    if (row >= MP) {
                        float* dst = out + O_GV + (size_t)(row - MP) * CC + c0;
#pragma unroll
                        for (int bj = 0; bj < 2; ++bj) { *(f32x4*)(dst + bj * 128) = acc[ai][bj][m][0]; *(f32x4*)(dst + bj * 128 + 4) = acc[ai][bj][m][1]; }
                    }
                }
        } else {
            const int b = pm - 36, hh = (pn - 44) & 3; const bool isv = pn >= 48;
            float* fo = out + (isv ? O_MV : O_MK);
#pragma unroll
            for (int ai = 0; ai < 2; ++ai)
#pragma unroll
                for (int m = 0; m < 4; ++m) {
                    const int mr = wr * 64 + fr + ai * 128 + m * 16;
                    const size_t rowg = (size_t)b * 256 + mr;
#pragma unroll
                    for (int bj = 0; bj < 2; ++bj) {
                        const f32x4 v0 = acc[ai][bj][m][0], v1 = acc[ai][bj][m][1];
                        const int d0 = bj * 128 + cl;
                        float* dst = fo + rowg * 1024 + hh * 256 + d0; *(f32x4*)dst = v0; *(f32x4*)(dst + 4) = v1;
                        if (!isv) {
                            u32x4 w; w.x = cvt_pk_bf16(v0[0], v0[1]); w.y = cvt_pk_bf16(v0[2], v0[3]); w.z = cvt_pk_bf16(v1[0], v1[1]); w.w = cvt_pk_bf16(v1[2], v1[3]);
                            *(u32x4*)(KB + rowg * 1024 + hh * 256 + d0) = w;
                        } else {
#pragma unroll
                            for (int j = 0; j < 4; ++j) { VTM[((size_t)(b * 4 + hh) * 256 + d0 + j) * 256 + mr] = f2bf(v0[j]); VTM[((size_t)(b * 4 + hh) * 256 + d0 + 4 + j) * 256 + mr] = f2bf(v1[j]); }
                        }
                    }
                }
        }
    }
};

struct Epi2F {
    const float* xp; const float* gpost; float* y; float* oss; unsigned* cnt;
    __device__ __forceinline__ void operator()(const f32x4 (&acc)[2][2][4][2], const pg8::Unit& u, int wr, int wc, int fr, int fq) const {
        asm volatile("" : "+v"(fr), "+v"(fq));
        const int rb = u.pm * 256 + wr * 64 + fr;
#pragma unroll
        for (int ai = 0; ai < 2; ++ai)
#pragma unroll
            for (int m = 0; m < 4; ++m) {
                float q = 0.f;
#pragma unroll
                for (int bj = 0; bj < 2; ++bj) {
                    const f32x4 v0 = acc[ai][bj][m][0], v1 = acc[ai][bj][m][1];
                    q += (v0[0] * v0[0] + v0[1] * v0[1]) + (v0[2] * v0[2] + v0[3] * v0[3]) + (v1[0] * v1[0] + v1[1] * v1[1]) + (v1[2] * v1[2] + v1[3] * v1[3]);
                }
                q += __shfl_xor(q, 16); q += __shfl_xor(q, 32);
                if (fq == 0) (void)__hip_atomic_fetch_add(oss + rb + ai * 128 + m * 16, q, __ATOMIC_RELAXED, __HIP_MEMORY_SCOPE_AGENT);
            }
        const int c0 = u.pn * 256 + wc * 32 + 8 * fq;
        f32x4 gp[2][2];
#pragma unroll
        for (int bj = 0; bj < 2; ++bj) { gp[bj][0] = *(const f32x4*)(gpost + c0 + bj * 128); gp[bj][1] = *(const f32x4*)(gpost + c0 + bj * 128 + 4); }
        f32x4 pre[2][2][2];
#pragma unroll
        for (int m = 0; m < 2; ++m)
#pragma unroll
            for (int bj = 0; bj < 2; ++bj) { const size_t off = (size_t)(rb + m * 16) * DM + c0 + bj * 128; pre[m][bj][0] = __builtin_nontemporal_load((const f32x4*)(xp + off)); pre[m][bj][1] = __builtin_nontemporal_load((const f32x4*)(xp + off + 4)); }
        asm volatile("s_waitcnt vmcnt(0)" ::: "memory");
        __builtin_amdgcn_s_barrier();
        if (threadIdx.x == 0) {
            unsigned* cw = cnt + 64 * u.pm;
            (void)__hip_atomic_fetch_add(cw, 1u, __ATOMIC_RELAXED, __HIP_MEMORY_SCOPE_AGENT);
            unsigned sp = 0;
            while (__hip_atomic_load(cw, __ATOMIC_RELAXED, __HIP_MEMORY_SCOPE_AGENT) < 16u) { __builtin_amdgcn_s_sleep(2); if (++sp > (1u << 22)) break; }
        }
        __builtin_amdgcn_s_barrier();
        asm volatile("" ::: "memory");
#pragma unroll
        for (int ai = 0; ai < 2; ++ai)
#pragma unroll
            for (int m = 0; m < 4; ++m) {
                const int row = rb + ai * 128 + m * 16;
                const float tot = __hip_atomic_load(oss + row, __ATOMIC_RELAXED, __HIP_MEMORY_SCOPE_AGENT);
                const float rs = rsqrtf(tot * (1.0f / DM) + EPS);
#pragma unroll
                for (int bj = 0; bj < 2; ++bj) {
                    const size_t off = (size_t)row * DM + c0 + bj * 128;
                    const f32x4 x0 = (ai == 0 && m < 2) ? pre[m & 1][bj][0] : __builtin_nontemporal_load((const f32x4*)(xp + off)), x1 = (ai == 0 && m < 2) ? pre[m & 1][bj][1] : __builtin_nontemporal_load((const f32x4*)(xp + off + 4));
                    __builtin_nontemporal_store(x0 + acc[ai][bj][m][0] * rs * gp[bj][0], (f32x4*)(y + off)); __builtin_nontemporal_store(x1 + acc[ai][bj][m][1] * rs * gp[bj][1], (f32x4*)(y + off + 4));
                }
            }
    }
};
struct EpiSlab {
    bf16_t* F; int ldf, pm0, pn0; size_t slab;
    __device__ __forceinline__ void operator()(const f32x4 (&acc)[2][2][4][2], const pg8::Unit& u, int wr, int wc, int fr, int fq) const {
        asm volatile("" : "+v"(fr), "+v"(fq));
        const int rb = (u.pm - pm0) * 256 + wr * 64 + fr;
        bf16_t* base = F + (size_t)(u.koff >> 10) * slab + (u.pn - pn0) * 256 + wc * 32 + 8 * fq;
#pragma unroll
        for (int ai = 0; ai < 2; ++ai)
#pragma unroll
            for (int m = 0; m < 4; ++m) {
                bf16_t* rp = base + (size_t)(rb + ai * 128 + m * 16) * ldf;
#pragma unroll
                for (int bj = 0; bj < 2; ++bj) { const f32x4 v0 = acc[ai][bj][m][0], v1 = acc[ai][bj][m][1];
                    u32x4 w; w.x = cvt_pk_bf16(v0[0], v0[1]); w.y = cvt_pk_bf16(v0[2], v0[3]); w.z = cvt_pk_bf16(v1[0], v1[1]); w.w = cvt_pk_bf16(v1[2], v1[3]);
                    __builtin_nontemporal_store(w, (u32x4*)(rp + bj * 128)); }
            }
    }
};

template <class EF>
struct EpiMix {
    EF f; EpiSlab q;
    __device__ __forceinline__ void operator()(const f32x4 (&acc)[2][2][4][2], const pg8::Unit& u, int wr, int wc, int fr, int fq) const {
        if (u.kt == 64) f(acc, u, wr, wc, fr, fq); else q(acc, u, wr, wc, fr, fq);
    }
};

__device__ __forceinline__ void transpose_item64(const float* __restrict__ W, int N, bf16_t* __restrict__ WT, int K, int k0, int n0, int drow0, LAS float* scr, int lane, const float* rowscale = nullptr) {
    const int lr = lane >> 4, lc = (lane & 15) * 4;
    f32x4 v[16];
#pragma unroll
    for (int i = 0; i < 16; ++i) v[i] = __builtin_nontemporal_load((const f32x4*)(W + (size_t)(k0 + 4 * i + lr) * N + n0 + lc));
    if (rowscale) {
#pragma unroll
        for (int i = 0; i < 16; ++i) v[i] *= rowscale[k0 + 4 * i + lr];
    }
#pragma unroll
    for (int i = 0; i < 16; ++i) { LAS float* p = scr + (4 * i + lr) * 65 + lc; p[0] = v[i][0]; p[1] = v[i][1]; p[2] = v[i][2]; p[3] = v[i][3]; }
    LDS_WAIT();
    const int c = lane & 7, nr = lane >> 3;
#pragma unroll
    for (int j = 0; j < 8; ++j) {
        const int n = nr + 8 * j; const LAS float* s = scr + (8 * c) * 65 + n;
        u32x4 o; o.x = cvt_pk_bf16(s[0], s[65]); o.y = cvt_pk_bf16(s[130], s[195]); o.z = cvt_pk_bf16(s[260], s[325]); o.w = cvt_pk_bf16(s[390], s[455]);
        *(u32x4*)(WT + (size_t)(drow0 + n0 + n) * K + k0 + 8 * c) = o;
    }
    LDS_WAIT();
}
__device__ __forceinline__ int win_dest_row(int n) {
    if (n < 1536) return 256 * (n >> 7) + (n & 127);
    if (n < 3072) { n -= 1536; return 256 * (n >> 7) + 128 + (n & 127); }
    if (n < 4608) return 256 * 24 + (n - 3072);
    if (n < 6144) { n -= 4608; return 256 * (12 + (n >> 7)) + (n & 127); }
    if (n < 7680) return 256 * 30 + (n - 6144);
    if (n < 9216) { n -= 7680; return 256 * (12 + (n >> 7)) + 128 + (n & 127); }
    if (n < 10240) return 256 * 36 + (n - 9216);
    return 256 * 40 + (n - 10240);
}
__device__ __forceinline__ void rms_row_bf16(const float* __restrict__ xrow, const float* __restrict__ g, bf16_t* __restrict__ orow, int lane) {
    f32x4 v[16]; float s = 0.f;
#pragma unroll
    for (int j = 0; j < 16; ++j) { v[j] = __builtin_nontemporal_load((const f32x4*)xrow + lane + 64 * j); s += (v[j][0] * v[j][0] + v[j][1] * v[j][1]) + (v[j][2] * v[j][2] + v[j][3] * v[j][3]); }
    s = wave_sum(s);
    const float r = rsqrtf(s * (1.0f / DM) + EPS);
#pragma unroll
    for (int j = 0; j < 16; ++j) {
        const f32x4 gg = ((const f32x4*)g)[lane + 64 * j];
        u32x2 o; o.x = cvt_pk_bf16(v[j][0] * r * gg[0], v[j][1] * r * gg[1]); o.y = cvt_pk_bf16(v[j][2] * r * gg[2], v[j][3] * r * gg[3]);
        ((u32x2*)orow)[lane + 64 * j] = o;
    }
}

#define XB_TMO      128
#define XB_XCNT(j)  (256  + 64 * (j))
#define XB_XSUB(j)  (1280 + 64 * (j))
#define XB_XGEN(j)  (2304 + 64 * (j))
#define XB_TOP      3328
#define XB_TOPGEN   3392
#define XB_SPIN_CAP (1u << 20)
__device__ __forceinline__ unsigned xb_ld(unsigned* p)              { return __hip_atomic_load(p, __ATOMIC_RELAXED, __HIP_MEMORY_SCOPE_AGENT); }
__device__ __forceinline__ unsigned xb_add(unsigned* p, unsigned v) { return __hip_atomic_fetch_add(p, v, __ATOMIC_RELAXED, __HIP_MEMORY_SCOPE_AGENT); }
__device__ __forceinline__ unsigned xb_xcc_id() { return (unsigned)__builtin_amdgcn_s_getreg((3 << 11) | 20) & 0xFu; }
#define XB_SPIN(cond, bar) do { unsigned _sp = 0; while (cond) { __builtin_amdgcn_s_sleep(1); \
    if ((++_sp & 255u) == 0u) { if (xb_ld(&(bar)[XB_TMO])) break; if (_sp > XB_SPIN_CAP) { atomicAdd(&(bar)[XB_TMO], 1u); break; } } } } while (0)
struct XcdBarrier { unsigned* bar; unsigned x; volatile LAS unsigned* st; };
__device__ __forceinline__ XcdBarrier xcd_barrier_post(unsigned* bar, volatile LAS unsigned* st) {
    XcdBarrier b; b.bar = bar; b.x = xb_xcc_id(); b.st = st;
    if (threadIdx.x == 0) (void)xb_add(&bar[XB_XCNT(b.x)], 1u);
    return b;
}
__device__ __forceinline__ void xcd_barrier_complete(unsigned* bar, unsigned x, unsigned& nloc, unsigned& nx) {
    const unsigned G = gridDim.x * gridDim.y * gridDim.z;
    unsigned sum, cnt, mine, sp = 0u;
    for (;;) {
        sum = 0u; cnt = 0u; mine = 0u;
#pragma unroll
        for (unsigned j = 0; j < 16; ++j) { const unsigned c = xb_ld(&bar[XB_XCNT(j)]); sum += c; cnt += (c > 0u) ? 1u : 0u; mine = (j == x) ? c : mine; }
        if (sum == G) break;
        __builtin_amdgcn_s_sleep(1);
        if ((++sp & 255u) == 0u) { if (xb_ld(&bar[XB_TMO])) break; if (sp > XB_SPIN_CAP) { atomicAdd(&bar[XB_TMO], 1u); break; } }
    }
    nloc = mine > 0u ? mine : 1u; nx = cnt > 0u ? cnt : 1u;
}
__device__ __forceinline__ void xcd_barrier(const XcdBarrier& b) {
    asm volatile("s_waitcnt vmcnt(0)" ::: "memory");
    __syncthreads();
    if (threadIdx.x == 0) {
        unsigned* bar = b.bar;
        __builtin_amdgcn_s_waitcnt(0);
        unsigned nloc = b.st[0], nx = b.st[1];
        if (nloc == 0u) { xcd_barrier_complete(bar, b.x, nloc, nx); b.st[0] = nloc; b.st[1] = nx; }
        const unsigned old = xb_add(&bar[XB_XSUB(b.x)], 1u);
        const unsigned gen = old / nloc;
        if (old + 1u == (gen + 1u) * nloc) {
            __builtin_amdgcn_fence(__ATOMIC_RELEASE, "agent");
            asm volatile("s_waitcnt vmcnt(0)" ::: "memory");
            const unsigned og = xb_add(&bar[XB_TOP], 1u);
            const unsigned tg = og / nx;
            if (og + 1u == (tg + 1u) * nx) xb_add(&bar[XB_TOPGEN], 1u);
            else XB_SPIN(xb_ld(&bar[XB_TOPGEN]) == tg, bar);
            __builtin_amdgcn_fence(__ATOMIC_ACQUIRE, "agent");
            xb_add(&bar[XB_XGEN(b.x)], 1u);
            asm volatile("s_waitcnt vmcnt(0)" ::: "memory");
        } else {
            XB_SPIN(xb_ld(&bar[XB_XGEN(b.x)]) == gen, bar);
            __builtin_amdgcn_fence(__ATOMIC_ACQUIRE, "agent");
            asm volatile("s_waitcnt vmcnt(0)" ::: "memory");
        }
    }
    __syncthreads();
}

struct Args {
    const float* in[22]; float* out; unsigned char* ws;
};

constexpr int KVB = 512;
__device__ __forceinline__ int kv_off(int row, int chunk) { return row * KVB + ((chunk ^ ((row & 15) ^ (((row >> 4) & 1) << 2))) << 4); }
constexpr int KVH = 128 * KVB;
__device__ __forceinline__ void attn_dma(const bf16_t* base, int pitch, LAS unsigned char* buf, int wave, int lane) {
#pragma unroll
    for (int i = 0; i < 8; ++i) {
        const int r = 2 * (8 * wave + i) + (lane >> 5), cs = lane & 31, cg = cs ^ ((r & 15) ^ (((r >> 4) & 1) << 2));
        __builtin_amdgcn_global_load_lds((const unsigned*)(base + (size_t)r * pitch + cg * 8), (LAS unsigned*)(buf + (8 * wave + i) * 1024), 16, 0, 0);
    }
}
#define ATTN_LAND() do { asm volatile("s_waitcnt vmcnt(0)" ::: "memory"); __syncthreads(); } while (0)
__device__ __forceinline__ float attn_epi8(const f32x4 (&o)[8], float inv, const bf16_t* P, bf16_t* MIX, int qrow, int c0, int g) {
    float ss = 0.f;
#pragma unroll
    for (int p = 0; p < 4; ++p) {
        const int c = c0 + 32 * p + 8 * g;
        const u32x4 sg = *(const u32x4*)(P + (size_t)qrow * PW + P_SGX + c);
        f32x4 y0 = o[2 * p] * inv, y1 = o[2 * p + 1] * inv;
        y0[0] *= bflo(sg.x); y0[1] *= bfhi(sg.x); y0[2] *= bflo(sg.y); y0[3] *= bfhi(sg.y);
        y1[0] *= bflo(sg.z); y1[1] *= bfhi(sg.z); y1[2] *= bflo(sg.w); y1[3] *= bfhi(sg.w);
        ss += ((y0[0] * y0[0] + y0[1] * y0[1]) + (y0[2] * y0[2] + y0[3] * y0[3])) + ((y1[0] * y1[0] + y1[1] * y1[1]) + (y1[2] * y1[2] + y1[3] * y1[3]));
        u32x4 w; w.x = cvt_pk_bf16(y0[0], y0[1]); w.y = cvt_pk_bf16(y0[2], y0[3]); w.z = cvt_pk_bf16(y1[0], y1[1]); w.w = cvt_pk_bf16(y1[2], y1[3]);
        *(u32x4*)(MIX + (size_t)qrow * DM + 3072 + c) = w;
    }
    return ss;
}
__device__ __forceinline__ void attn_unit(int a, const bf16_t* P, const bf16_t* QF, const bf16_t* KB, const bf16_t* VTM, const float* g_branch,
                                          bf16_t* MIX, LAS unsigned char* kv, int tid, int wave, int lane) {
    int row0, bm, nq;
    if (a < 64) { row0 = a * 128; bm = a >> 5; nq = 8; } else { row0 = MP + (a - 64) * 64; bm = 2 + (a - 64); nq = 4; }
    const bool active = wave < nq;
    const int l150 = lane & 15, g0 = lane >> 4, l15 = l150, g = g0;
    const int qrow = row0 + 16 * (active ? wave : 0) + l15;
    const bf16_t* kg = KB + (size_t)(bm * 256) * 1024;
    const bf16_t* vg = VTM + (size_t)(bm * 4) * 256 * 256;
    const int krow0 = 8 * (l15 >> 2) + (l15 & 3);
    LAS unsigned char* bufA = kv; LAS unsigned char* bufB = kv + KVH;
    attn_dma(kg, 1024, bufA, wave, opq(lane));
    ATTN_LAND();
    float ss = 0.f;
#pragma unroll 1
    for (int h = 0; h < 4; ++h) {
        attn_dma(kg + h * 256 + (size_t)128 * 1024, 1024, bufB, wave, opq(lane));
        bf16x8 qf[8];
        if (active) {
            if (row0 < 4096) {
#pragma unroll
                for (int ks = 0; ks < 8; ++ks) {
                    const bf16_t* qp = QF + (size_t)qrow * CX + h * 256 + 32 * ks + 8 * g;
                    const u32x4 p0 = *(const u32x4*)qp, p1 = *(const u32x4*)(qp + SLAB), p2 = *(const u32x4*)(qp + 2 * SLAB), p3 = *(const u32x4*)(qp + 3 * SLAB);
                    u32x4 w;
#pragma unroll
                    for (int e = 0; e < 4; ++e) w[e] = cvt_pk_bf16(((bflo(p0[e]) + bflo(p1[e])) + (bflo(p2[e]) + bflo(p3[e]))) * QSCALE, ((bfhi(p0[e]) + bfhi(p1[e])) + (bfhi(p2[e]) + bfhi(p3[e]))) * QSCALE);
                    qf[ks] = __builtin_bit_cast(bf16x8, w);
                }
            } else {
#pragma unroll
                for (int ks = 0; ks < 8; ++ks) qf[ks] = *(const bf16x8*)(P + (size_t)qrow * PW + P_Q + h * 256 + 32 * ks + 8 * g);
            }
        }
        f32x4 s[16];
        if (active) {
            const int krow = opq(krow0), g = opq(g0);
#pragma unroll
            for (int kt = 0; kt < 16; ++kt) s[kt] = (f32x4){0.f, 0.f, 0.f, 0.f};
#pragma unroll
            for (int ks = 0; ks < 8; ++ks)
                {
#pragma unroll
                  for (int kt = 0; kt < 8; ++kt) s[kt] = __builtin_amdgcn_mfma_f32_16x16x32_bf16(*(const LAS bf16x8*)(bufA + kv_off(32 * (kt >> 1) + 4 * (kt & 1) + krow, 4 * ks + g)), qf[ks], s[kt], 0, 0, 0);
                  __builtin_amdgcn_sched_barrier(0); }
        }
        ATTN_LAND();
        attn_dma(vg + (size_t)h * 256 * 256, 256, bufA, wave, opq(lane));
        bf16x8 pf[8]; float inv = 0.f;
        if (active) {
            const int krow = opq(krow0), g = opq(g0);
#pragma unroll
            for (int ks = 0; ks < 8; ++ks)
                {
#pragma unroll
                  for (int kt = 8; kt < 16; ++kt) s[kt] = __builtin_amdgcn_mfma_f32_16x16x32_bf16(*(const LAS bf16x8*)(bufB + kv_off(32 * ((kt - 8) >> 1) + 4 * (kt & 1) + krow, 4 * ks + g)), qf[ks], s[kt], 0, 0, 0);
                  __builtin_amdgcn_sched_barrier(0); }
            float mx = s[0][0];
#pragma unroll
            for (int kt = 0; kt < 16; ++kt)
#pragma unroll
                for (int j = 0; j < 4; ++j) mx = fmaxf(mx, s[kt][j]);
            mx = fmaxf(mx, __shfl_xor(mx, 16)); mx = fmaxf(mx, __shfl_xor(mx, 32));
            float l = 0.f;
#pragma unroll
            for (int kt = 0; kt < 16; ++kt)
#pragma unroll
                for (int j = 0; j < 4; ++j) { const float p = __builtin_amdgcn_exp2f(s[kt][j] - mx); s[kt][j] = p; l += p; }
            l += __shfl_xor(l, 16); l += __shfl_xor(l, 32);
            inv = 1.0f / l;
#pragma unroll
            for (int si = 0; si < 8; ++si) {
                u32x4 w; w.x = cvt_pk_bf16(s[2 * si][0], s[2 * si][1]); w.y = cvt_pk_bf16(s[2 * si][2], s[2 * si][3]);
                w.z = cvt_pk_bf16(s[2 * si + 1][0], s[2 * si + 1][1]); w.w = cvt_pk_bf16(s[2 * si + 1][2], s[2 * si + 1][3]);
                pf[si] = __builtin_bit_cast(bf16x8, w);
            }
        }
        ATTN_LAND();
        attn_dma(vg + (size_t)h * 256 * 256 + (size_t)128 * 256, 256, bufB, wave, opq(lane));
        if (active) {
            const int krow = opq(krow0), g = opq(g0);
            f32x4 o[8];
#pragma unroll
            for (int dt = 0; dt < 8; ++dt) o[dt] = (f32x4){0.f, 0.f, 0.f, 0.f};
#pragma unroll
            for (int si = 0; si < 8; ++si)
                {
#pragma unroll
                  for (int dt = 0; dt < 8; ++dt) o[dt] = __builtin_amdgcn_mfma_f32_16x16x32_bf16(*(const LAS bf16x8*)(bufA + kv_off(32 * (dt >> 1) + 4 * (dt & 1) + krow, 4 * si + g)), pf[si], o[dt], 0, 0, 0);
                  __builtin_amdgcn_sched_barrier(0); }
            ss += attn_epi8(o, inv, P, MIX, qrow, h * 256, g);
        }
        ATTN_LAND();
        if (h < 3) attn_dma(kg + (h + 1) * 256, 1024, bufA, wave, opq(lane));
        if (active) {
            const int krow = opq(krow0), g = opq(g0);
            f32x4 o[8];
#pragma unroll
            for (int dt = 0; dt < 8; ++dt) o[dt] = (f32x4){0.f, 0.f, 0.f, 0.f};
#pragma unroll
            for (int si = 0; si < 8; ++si)
                {
#pragma unroll
                  for (int dt = 0; dt < 8; ++dt) o[dt] = __builtin_amdgcn_mfma_f32_16x16x32_bf16(*(const LAS bf16x8*)(bufB + kv_off(32 * (dt >> 1) + 4 * (dt & 1) + krow, 4 * si + g)), pf[si], o[dt], 0, 0, 0);
                  __builtin_amdgcn_sched_barrier(0); }
            ss += attn_epi8(o, inv, P, MIX, qrow, h * 256 + 128, g);
        }
        ATTN_LAND();
    }
    if (active) {
        ss += __shfl_xor(ss, 16); ss += __shfl_xor(ss, 32);
        const float rs = rsqrtf(ss * (1.0f / CX) + EPS);
        asm volatile("s_waitcnt vmcnt(0)" ::: "memory");
#pragma unroll 1
        for (int b = 0; b < 4; ++b) {
            bf16_t* mp = MIX + (size_t)qrow * DM + 3072 + 256 * b + 8 * g;
            u32x4 yv[8];
#pragma unroll
            for (int i = 0; i < 8; ++i) yv[i] = *(const u32x4*)(mp + 32 * i);
#pragma unroll
            for (int i = 0; i < 8; ++i) {
                u32x4 w; w.x = cvt_pk_bf16(bflo(yv[i].x) * rs, bfhi(yv[i].x) * rs); w.y = cvt_pk_bf16(bflo(yv[i].y) * rs, bfhi(yv[i].y) * rs);
                w.z = cvt_pk_bf16(bflo(yv[i].z) * rs, bfhi(yv[i].z) * rs); w.w = cvt_pk_bf16(bflo(yv[i].w) * rs, bfhi(yv[i].w) * rs);
                *(u32x4*)(mp + 32 * i) = w;
            }
        }
    }
    __syncthreads();
}

__device__ __forceinline__ void gmlp_unit(int u, const bf16_t* P, const bf16_t* VT, const float* vstat, const float* Ws, const float* bsp,
                                          const float* lvg, const float* lvb, const float* g_branch, float* GV, bf16_t* MIX,
                                          LAS float* sm, int tid, int wave, int lane) {
    int row0, ib; bool sample;
    if (u < 512) { row0 = (u >> 3) * 128; ib = u & 7; sample = false; } else { const int v = u - 512; row0 = MP + (v >> 2) * 64; ib = v & 3; sample = true; }
    const int i0 = 16 * ib, nks = (i0 + 47) >> 5, nj = i0 + 16;
    LAS float* sm_mean = sm; LAS float* sm_rstd = sm + 128; LAS float* sm_part = sm + 256;
    if (tid < 128) {
        float mean = 0.f, rstd = 0.f;
        if (tid < nj) { const float s1 = vstat[2 * (row0 + tid)], s2 = vstat[2 * (row0 + tid) + 1]; mean = s1 * (1.0f / CC); const float var = fmaxf(s2 * (1.0f / CC) - mean * mean, 0.f); rstd = rsqrtf(var + EPS); }
        sm_mean[tid] = mean; sm_rstd[tid] = rstd;
    }
    __syncthreads();
    if (sample && GV) {
        float* gv = GV + (size_t)(row0 - MP + i0) * CC;
        for (int e = tid; e < 16 * 384; e += NTHREADS) {
            const int r = e / 384, c4 = (e - r * 384) * 4;
            f32x4 v = *(f32x4*)(gv + (size_t)r * CC + c4); const f32x4 gg = *(const f32x4*)(lvg + c4), bb = *(const f32x4*)(lvb + c4);
            const float mean = sm_mean[i0 + r], rstd = sm_rstd[i0 + r];
            v = (v - mean) * rstd * gg + bb;
            *(f32x4*)(gv + (size_t)r * CC + c4) = v;
        }
    }
    const int h = wave >> 1, cw0 = 192 * wave, l15 = lane & 15, g = lane >> 4;
    const int i = i0 + l15;
    bf16x8 wf[4]; float c1 = 0.f, c2 = 0.f;
    {
        const float* wrow = Ws + ((size_t)h * 128 + i) * 128;
#pragma unroll
        for (int ks = 0; ks < 4; ++ks) {
            u32x4 w = (u32x4){0u, 0u, 0u, 0u};
            if (ks < nks) {
                const int j0 = 32 * ks + 8 * g; const f32x4 w0 = *(const f32x4*)(wrow + j0), w1 = *(const f32x4*)(wrow + j0 + 4);
                const f32x4 r0 = *(const LAS f32x4*)(sm_rstd + j0), r1 = *(const LAS f32x4*)(sm_rstd + j0 + 4), m0 = *(const LAS f32x4*)(sm_mean + j0), m1 = *(const LAS f32x4*)(sm_mean + j0 + 4);
                float wv[8] = {w0[0], w0[1], w0[2], w0[3], w1[0], w1[1], w1[2], w1[3]};
                const float rv[8] = {r0[0], r0[1], r0[2], r0[3], r1[0], r1[1], r1[2], r1[3]}, mv[8] = {m0[0], m0[1], m0[2], m0[3], m1[0], m1[1], m1[2], m1[3]};
#pragma unroll
                for (int e = 0; e < 8; ++e) { const int j = j0 + e; const float wm = (j <= i) ? wv[e] : 0.f; const float wp = wm * rv[e]; c1 += wp * mv[e]; c2 += wm; wv[e] = wp; }
                w.x = cvt_pk_bf16(wv[0], wv[1]); w.y = cvt_pk_bf16(wv[2], wv[3]); w.z = cvt_pk_bf16(wv[4], wv[5]); w.w = cvt_pk_bf16(wv[6], wv[7]);
            }
            wf[ks] = __builtin_bit_cast(bf16x8, w);
        }
        c1 += __shfl_xor(c1, 16); c1 += __shfl_xor(c1, 32); c2 += __shfl_xor(c2, 16); c2 += __shfl_xor(c2, 32);
    }
    f32x4 z[12];
#pragma unroll
    for (int nt = 0; nt < 12; ++nt) z[nt] = (f32x4){0.f, 0.f, 0.f, 0.f};
#pragma unroll
    for (int nt = 0; nt < 12; ++nt) {
        const bf16_t* vp = VT + (size_t)(cw0 + 16 * nt + l15) * MT + row0 + 8 * g;
#pragma unroll
        for (int ks = 0; ks < 4; ++ks) if (ks < nks) {
            const bf16x8 vf = *(const bf16x8*)(vp + 32 * ks);
            z[nt] = __builtin_amdgcn_mfma_f32_16x16x32_bf16(vf, wf[ks], z[nt], 0, 0, 0);
        }
    }
    const float bs = bsp[h * 128 + i];
    const int row = row0 + i;
    float ss = 0.f;
#pragma unroll
    for (int nt = 0; nt < 12; ++nt) {
        const int c = cw0 + 16 * nt + 4 * g; const f32x4 gv = *(const f32x4*)(lvg + c), bv = *(const f32x4*)(lvb + c);
        const u32x2 ug = *(const u32x2*)(P + (size_t)row * PW + P_UG + c);
        const float uu[4] = {bflo(ug.x), bfhi(ug.x), bflo(ug.y), bfhi(ug.y)};
        f32x4 y;
#pragma unroll
        for (int j = 0; j < 4; ++j) { const float zz = gv[j] * (z[nt][j] - c1) + bv[j] * c2 + bs; y[j] = uu[j] * zz; }
        z[nt] = y; ss += (y[0] * y[0] + y[1] * y[1]) + (y[2] * y[2] + y[3] * y[3]);
    }
    ss += __shfl_xor(ss, 16); ss += __shfl_xor(ss, 32);
    if (g == 0) sm_part[wave * 16 + l15] = ss;
    __syncthreads();
    {
        float tot = 0.f;
#pragma unroll
        for (int w = 0; w < 8; ++w) tot += sm_part[w * 16 + l15];
        const float rs = rsqrtf(tot * (1.0f / CC) + EPS);
#pragma unroll
        for (int nt = 0; nt < 12; ++nt) {
            const int c = cw0 + 16 * nt + 4 * g;
            const f32x4 y = z[nt] * rs;
            u32x2 w; w.x = cvt_pk_bf16(y[0], y[1]); w.y = cvt_pk_bf16(y[2], y[3]);
            *(u32x2*)(MIX + (size_t)row * DM + CC + c) = w;
        }
    }
    __syncthreads();
}

__device__ __forceinline__ void conv_unit(int a, const bf16_t* P, const bf16_t* GLU, const float* cw, const float* cb,
                                          const float* lg, const float* lb, const float* g_branch, bf16_t* MIX,
                                          LAS float* cbuf, int tid, int wave, int lane) {
    const int row0 = 16 * a;
    const bf16_t* gbase = GLU + (size_t)(glu_row(row0) - 30) * CC;
    const __amdgpu_buffer_rsrc_t rx = __builtin_amdgcn_make_buffer_rsrc((void*)gbase, 0, 46 * CC * 2, 0x00020000);
    const __amdgpu_buffer_rsrc_t rw = __builtin_amdgcn_make_buffer_rsrc((void*)cw, 0, 31 * CC * 4, 0x00020000);
#pragma unroll 1
    for (int it = 0; it < 2; ++it) {
        const int cp = tid + 512 * it;
        if (cp < CC / 2) {
            float w[31][2];
#pragma unroll
            for (int j = 0; j < 31; ++j) { w[j][0] = __builtin_bit_cast(float, __builtin_amdgcn_raw_buffer_load_b32(rw, cp * 8, j * CC * 4, 0)); w[j][1] = __builtin_bit_cast(float, __builtin_amdgcn_raw_buffer_load_b32(rw, cp * 8 + 4, j * CC * 4, 0)); }
            float acc[16][2];
            const float b0 = cb[2 * cp], b1 = cb[2 * cp + 1];
#pragma unroll
            for (int tt = 0; tt < 16; ++tt) { acc[tt][0] = b0; acc[tt][1] = b1; }
#pragma unroll
            for (int r = 0; r < 46; ++r) {
                const unsigned xv = (unsigned)__builtin_amdgcn_raw_buffer_load_b32(rx, cp * 4, r * CC * 2, 0);
                const float x0 = bflo(xv), x1 = bfhi(xv);
#pragma unroll
                for (int tt = 0; tt < 16; ++tt) if (r - tt >= 0 && r - tt <= 30) { acc[tt][0] += w[r - tt][0] * x0; acc[tt][1] += w[r - tt][1] * x1; }
            }
#pragma unroll
            for (int tt = 0; tt < 16; ++tt) { LAS float* d = cbuf + tt * CC + 2 * cp; d[0] = acc[tt][0]; d[1] = acc[tt][1]; }
        }
    }
    __syncthreads();
#pragma unroll
    for (int ti = 0; ti < 2; ++ti) {
        const int tt = 2 * wave + ti, row = row0 + tt;
        f32x4 v[6]; float s1 = 0.f, s2 = 0.f;
#pragma unroll
        for (int i = 0; i < 6; ++i) { v[i] = *(const LAS f32x4*)(cbuf + tt * CC + 4 * lane + 256 * i);
            s1 += (v[i][0] + v[i][1]) + (v[i][2] + v[i][3]); s2 += (v[i][0] * v[i][0] + v[i][1] * v[i][1]) + (v[i][2] * v[i][2] + v[i][3] * v[i][3]); }
        s1 = wave_sum(s1); s2 = wave_sum(s2);
        const float mean = s1 * (1.0f / CC), var = fmaxf(s2 * (1.0f / CC) - mean * mean, 0.f), rstd = rsqrtf(var + EPS);
        float q = 0.f;
#pragma unroll
        for (int i = 0; i < 6; ++i) {
            const int c = 4 * lane + 256 * i;
            const f32x4 gg = *(const f32x4*)(lg + c), bb = *(const f32x4*)(lb + c);
            const u32x2 sg = *(const u32x2*)(P + (size_t)row * PW + P_SGC + c);
            const float sv[4] = {bflo(sg.x), bfhi(sg.x), bflo(sg.y), bfhi(sg.y)};
#pragma unroll
            for (int j = 0; j < 4; ++j) { float y = (v[i][j] - mean) * rstd * gg[j] + bb[j]; y = y * sigmoidf_(y) * sv[j]; v[i][j] = y; q += y * y; }
        }
        q = wave_sum(q);
        const float rs = rsqrtf(q * (1.0f / CC) + EPS);
#pragma unroll
        for (int i = 0; i < 6; ++i) {
            const int c = 4 * lane + 256 * i;
            const f32x4 y = v[i] * rs;
            u32x2 o; o.x = cvt_pk_bf16(y[0], y[1]); o.y = cvt_pk_bf16(y[2], y[3]);
            *(u32x2*)(MIX + (size_t)row * DM + c) = o;
        }
    }
    __syncthreads();
}

__global__ void __launch_bounds__(NTHREADS, 2) mega_fwd(Args args) {
    extern __shared__ __attribute__((aligned(16))) unsigned char lds_raw[];
    LAS unsigned char* lds = (LAS unsigned char*)lds_raw;
    cg::grid_group grid = cg::this_grid();
    const int tid = threadIdx.x, lane = tid & 63, wave = __builtin_amdgcn_readfirstlane(tid >> 6);
    const int G = gridDim.x, bx = blockIdx.x;
    unsigned char* ws = args.ws;
    float* out = args.out;
    const float* x_prompt = args.in[0]; const float* x_sample = args.in[1]; const float* mem_prompt = args.in[2];
    const float* cache_k = args.in[3]; const float* cache_v = args.in[4]; const float* cache_conv = args.in[5];
    const float* g_pre = args.in[6]; const float* w_in = args.in[7]; const float* conv_w = args.in[8]; const float* conv_b = args.in[9];
    const float* ln_conv_g = args.in[10]; const float* ln_conv_b = args.in[11]; const float* ln_v_g = args.in[12]; const float* ln_v_b = args.in[13];
    const float* w_spatial = args.in[14]; const float* b_spatial = args.in[15]; const float* g_mem = args.in[16]; const float* w_mk = args.in[17]; const float* w_mv = args.in[18];
    const float* g_branch = args.in[19]; const float* w_out = args.in[20]; const float* g_post = args.in[21];
    unsigned* ctl = (unsigned*)(ws + WS_CTL);
    volatile LAS unsigned* bst = (volatile LAS unsigned*)(lds + LDS_BYTES - 16);
    if (tid < 4) bst[tid] = 0u;
    __syncthreads();
    const XcdBarrier xbar = xcd_barrier_post((unsigned*)(ws + CTL_BAR), bst);
    float* vstat = (float*)(ws + CTL_VSTAT); float* oss = (float*)(ws + CTL_OSS);
    bf16_t* WT = (bf16_t*)(ws + WS_WT); bf16_t* WO = (bf16_t*)(ws + WS_WO); bf16_t* H = (bf16_t*)(ws + WS_H); bf16_t* PB = (bf16_t*)(ws + WS_P);
    bf16_t* VT = (bf16_t*)(ws + WS_VT); bf16_t* KB = (bf16_t*)(ws + WS_KB); bf16_t* VTM = (bf16_t*)(ws + WS_VTM); bf16_t* MIX = (bf16_t*)(ws + WS_MIX); bf16_t* OB = (bf16_t*)(ws + WS_OUT); bf16_t* GLU = (bf16_t*)(ws + WS_GLU); bf16_t* QF = (bf16_t*)(ws + WS_QF); bf16_t* OF = (bf16_t*)(ws + WS_OF);

#ifndef REP_P0
#define REP_P0 1
#endif
#ifndef REP_P2
#define REP_P2 1
#endif
#ifndef REP_P4
#define REP_P4 1
#endif
    for (int rep0 = 0; rep0 < REP_P0; ++rep0) {
        const int gw = bx * 8 + wave, NGW = G * 8;
        LAS float* scr = (LAS float*)(lds + wave * 16640);
        constexpr int I_IN = 64 * 176, I_MK = 64 * 16, I_CV = 16 * 64, NITEMS = I_IN + 2 * I_MK + I_CV;
        for (int it = gw; it < NITEMS; it += NGW) {
            int r = it;
            if (r < I_IN) { const int kb = r / 176, nb = r - kb * 176; transpose_item64(w_in, NIN, WT, DM, 64 * kb, 64 * nb, win_dest_row(64 * nb) - 64 * nb, scr, lane); continue; } r -= I_IN;
            if (r < I_MK) { const int kb = r >> 4, nb = r & 15; transpose_item64(w_mk, CX, WT, DM, 64 * kb, 64 * nb, NIN, scr, lane); continue; } r -= I_MK;
            if (r < I_MK) { const int kb = r >> 4, nb = r & 15; transpose_item64(w_mv, CX, WT, DM, 64 * kb, 64 * nb, NIN + CX, scr, lane); continue; } r -= I_MK;
            { const int b = r >> 6, q = r & 63, kb = q >> 4, nb = q & 15; transpose_item64(cache_v + (size_t)b * 256 * 1024, 1024, VTM + (size_t)(2 + b) * 1024 * 256, 256, 64 * kb, 64 * nb, 0, scr, lane); }
        }
        for (int m = gw; m < MT + MEMR; m += NGW) {
            const float* src; const float* gg;
            if (m < MP) { src = x_prompt + (size_t)m * DM; gg = g_pre; } else if (m < MT) { src = x_sample + (size_t)(m - MP) * DM; gg = g_pre; } else { src = mem_prompt + (size_t)(m - MT) * DM; gg = g_mem; }
            rms_row_bf16(src, gg, H + (size_t)m * DM, lane);
        }
        for (int i = gw * 64 + lane; i < 16 * 256 * 1024 / 4; i += NGW * 64) {
            const f32x4 v = __builtin_nontemporal_load((const f32x4*)cache_k + i);
            u32x2 o; o.x = cvt_pk_bf16(v[0], v[1]); o.y = cvt_pk_bf16(v[2], v[3]);
            ((u32x2*)(KB + (size_t)2 * 256 * 1024))[i] = o;
        }
        for (int i = gw * 64 + lane; i < 18 * 30 * CC / 4; i += NGW * 64) {
            const int hr = i / (CC / 4), c4 = i - hr * (CC / 4), b = hr / 30, r = hr - b * 30;
            u32x2 o = (u32x2){0u, 0u};
            if (b >= 2) { const f32x4 v = ((const f32x4*)cache_conv)[i - 2 * 30 * CC / 4]; o.x = cvt_pk_bf16(v[0], v[1]); o.y = cvt_pk_bf16(v[2], v[3]); }
            const int grow = (b < 2 ? b * 4126 : 8252 + (b - 2) * 94) + r;
            ((u32x2*)(GLU + (size_t)grow * CC))[c4] = o;
        }
    }
    if (gridDim.y == 0x7fffu) grid.sync();
    xcd_barrier(xbar);

    {
#ifndef NO_G1
        { pg8::Gemm g{H, WT, DM}; Sched1 S{bx}; EpiMix<Epi1> E{Epi1{PB, GLU, VT, vstat, out, KB, VTM}, EpiSlab{QF, CX, 0, 36, SLAB}};
          pg8::gemm_phase<EpiMix<Epi1>, Sched1>(lds, g, S, E); }
#endif
    }
    xcd_barrier(xbar);

    for (int rep2 = 0; rep2 < REP_P2; ++rep2) {
        LAS float* cbuf = (LAS float*)lds;
        LAS float* sm = (LAS float*)(lds + 135168);
        LAS int* sm_next = (LAS int*)(lds + 135168 + 4096);
        constexpr int NA = 80, NC = 576, NB = 576, NW = 512, NU = NA + NC + NB + NW;
        for (;;) {
            if (tid == 0) *sm_next = (int)atomicAdd(ctl + 64 * rep2, 1u);
            __syncthreads();
            const int u = __builtin_amdgcn_readfirstlane(*sm_next);
            __syncthreads();
            if (u >= NU) break;
            int tidv = tid, wv = wave;
            asm volatile("" : "+v"(tidv), "+s"(wv));
            tidv &= 511; wv &= 7;
            const int lanev = tidv & 63;
#ifndef P2_MASK
#define P2_MASK 7
#endif
            const int pmask = rep2 == 0 ? 7 : P2_MASK;
            if (u >= NA + NC + NB) {
                const int it = 8 * (u - NA - NC - NB) + wv;
                transpose_item64(w_out, DM, WO, DM, 64 * (it >> 6), 64 * (it & 63), 0, (LAS float*)(lds + wv * 16640), lanev, g_branch);
                __syncthreads();
            } else if (u < NA) {
                if (pmask & 1) {
#ifndef NO_ATTN
                attn_unit(u, PB, QF, KB, VTM, g_branch, MIX, lds, tidv, wv, lanev);
#endif
                }
            } else if (u >= NA + NB) {
                if (pmask & 2) {
#ifndef NO_CONV
                conv_unit(u - NA - NB, PB, GLU, conv_w, conv_b, ln_conv_g, ln_conv_b, g_branch, MIX, cbuf, tidv, wv, lanev);
#endif
                }
            } else {
                if (pmask & 4) {
#ifndef NO_GMLP
                gmlp_unit(u - NA, PB, VT, vstat, w_spatial, b_spatial, ln_v_g, ln_v_b, g_branch, rep2 == 0 ? out + O_GV : nullptr, MIX, sm, tidv, wv, lanev);
#endif
                }
            }
        }
    }
    xcd_barrier(xbar);

    {
#ifndef NO_G2
        { pg8::Gemm g{MIX, WO, DM}; Sched2 S{bx}; EpiMix<Epi2F> E{Epi2F{x_prompt, g_post, out + O_Y, oss, (unsigned*)(ws + CTL_PCNT)}, EpiSlab{OF, DM, 32, 0, SLAB}};
          pg8::gemm_phase<EpiMix<Epi2F>, Sched2>(lds, g, S, E); }
#endif
    }
    xcd_barrier(xbar);

    for (int rep4 = 0; rep4 < REP_P4; ++rep4) {
        const int lane = opq(tid) & 63;
        const int gw = bx * 8 + wave, NGW = G * 8;
        for (int m = MP + gw; m < MT; m += NGW) {
            float* yr = out + O_Y + (size_t)m * DM;
            if (m < MP) {
                const float* xr = x_prompt + (size_t)m * DM; const bf16_t* orow = OB + (size_t)m * DM;
                u32x4 ov[8]; f32x4 xv[16]; float q = 0.f;
#pragma unroll
                for (int j = 0; j < 8; ++j) ov[j] = *(const u32x4*)(orow + (lane + 64 * j) * 8);
#pragma unroll
                for (int j = 0; j < 8; ++j) { xv[2 * j] = *(const f32x4*)(xr + (lane + 64 * j) * 8); xv[2 * j + 1] = *(const f32x4*)(xr + (lane + 64 * j) * 8 + 4); }
#pragma unroll
                for (int j = 0; j < 8; ++j) {
                    const float a0 = bflo(ov[j].x), a1 = bfhi(ov[j].x), a2 = bflo(ov[j].y), a3 = bfhi(ov[j].y), a4 = bflo(ov[j].z), a5 = bfhi(ov[j].z), a6 = bflo(ov[j].w), a7 = bfhi(ov[j].w);
                    q += (a0 * a0 + a1 * a1) + (a2 * a2 + a3 * a3) + (a4 * a4 + a5 * a5) + (a6 * a6 + a7 * a7); }
                q = wave_sum(q);
                const float rs = rsqrtf(q * (1.0f / DM) + EPS);
#pragma unroll
                for (int j = 0; j < 8; ++j) {
                    const int c = (lane + 64 * j) * 8;
                    const f32x4 x0 = xv[2 * j], x1 = xv[2 * j + 1], g0 = *(const f32x4*)(g_post + c), g1 = *(const f32x4*)(g_post + c + 4);
                    f32x4 y0, y1;
                    y0[0] = x0[0] + bflo(ov[j].x) * rs * g0[0]; y0[1] = x0[1] + bfhi(ov[j].x) * rs * g0[1]; y0[2] = x0[2] + bflo(ov[j].y) * rs * g0[2]; y0[3] = x0[3] + bfhi(ov[j].y) * rs * g0[3];
                    y1[0] = x1[0] + bflo(ov[j].z) * rs * g1[0]; y1[1] = x1[1] + bfhi(ov[j].z) * rs * g1[1]; y1[2] = x1[2] + bflo(ov[j].w) * rs * g1[2]; y1[3] = x1[3] + bfhi(ov[j].w) * rs * g1[3];
                    *(f32x4*)(yr + c) = y0; *(f32x4*)(yr + c + 4) = y1;
                }
            } else {
                const float* xr = x_sample + (size_t)(m - MP) * DM; const bf16_t* orow = OF + (size_t)(m - MP) * DM;
                f32x4 ov[16]; float q = 0.f;
#pragma unroll
                for (int j = 0; j < 16; ++j) { const bf16_t* op = orow + (lane + 64 * j) * 4;
                    const u32x2 p0 = *(const u32x2*)op, p1 = *(const u32x2*)(op + SLAB), p2 = *(const u32x2*)(op + 2 * SLAB), p3 = *(const u32x2*)(op + 3 * SLAB);
                    ov[j][0] = (bflo(p0.x) + bflo(p1.x)) + (bflo(p2.x) + bflo(p3.x)); ov[j][1] = (bfhi(p0.x) + bfhi(p1.x)) + (bfhi(p2.x) + bfhi(p3.x));
                    ov[j][2] = (bflo(p0.y) + bflo(p1.y)) + (bflo(p2.y) + bflo(p3.y)); ov[j][3] = (bfhi(p0.y) + bfhi(p1.y)) + (bfhi(p2.y) + bfhi(p3.y));
                    q += (ov[j][0] * ov[j][0] + ov[j][1] * ov[j][1]) + (ov[j][2] * ov[j][2] + ov[j][3] * ov[j][3]); }
                q = wave_sum(q);
                const float rs = rsqrtf(q * (1.0f / DM) + EPS);
#pragma unroll
                for (int j = 0; j < 16; ++j) {
                    const int c = (lane + 64 * j) * 4;
                    const f32x4 x0 = __builtin_nontemporal_load((const f32x4*)(xr + c)), g0 = *(const f32x4*)(g_post + c);
                    __builtin_nontemporal_store(x0 + ov[j] * rs * g0, (f32x4*)(yr + c));
                }
            }
        }
    }
}

extern "C" void kernel_launch(void* const* d_in, const int* in_sizes, int n_in, void* d_out, int out_size, void* d_ws, size_t ws_size, hipStream_t stream) {
    static int grid = 0;
    if (grid == 0) {
        if (n_in != 22 || ws_size < WS_END) { fprintf(stderr, "kernel_launch: unexpected inputs (n_in %d, ws %zu)\n", n_in, ws_size); grid = -1; return; }
        int dev = 0, cus = 0, per_cu = 0;
        (void)hipGetDevice(&dev);
        (void)hipDeviceGetAttribute(&cus, hipDeviceAttributeMultiprocessorCount, dev);
        if (hipFuncSetAttribute((const void*)mega_fwd, hipFuncAttributeMaxDynamicSharedMemorySize, LDS_BYTES) != hipSuccess) { fprintf(stderr, "kernel_launch: hipFuncSetAttribute failed\n"); grid = -1; return; }
        if (hipOccupancyMaxActiveBlocksPerMultiprocessor(&per_cu, (const void*)mega_fwd, NTHREADS, LDS_BYTES) != hipSuccess || per_cu < 1) { fprintf(stderr, "kernel_launch: occupancy query says %d\n", per_cu); per_cu = 1; }
        (void)hipGetLastError();
        grid = 256;
        if (cus != 256) fprintf(stderr, "kernel_launch: built for a 256-CU device, found %d CUs\n", cus);
    }
    if (grid < 0) return;
    (void)hipMemsetAsync((char*)d_ws + WS_CTL, 0, CTL_BYTES, stream);
    Args a{};
    for (int i = 0; i < 22; ++i) a.in[i] = (const float*)d_in[i];
    a.out = (float*)d_out; a.ws = (unsigned char*)d_ws;
    void* kargs[] = {&a};
    hipError_t e = hipLaunchCooperativeKernel((const void*)mega_fwd, dim3(grid), dim3(NTHREADS), kargs, LDS_BYTES, stream);
    if (e != hipSuccess) fprintf(stderr, "kernel_launch: cooperative launch failed: %s (grid %d)\n", hipGetErrorString(e), grid);
}
```
